# Optimizing an MI355X kernel written in HIP

```python
import math
import jax, jax.numpy as jnp
from jax import lax
import numpy as np


D_MODEL = 1024
BATCH = 16
SEQ = 2048
DEPTH = 2

HEAD_DIM = 64
FOX_HEADS = 4
FOX_W = FOX_HEADS * HEAD_DIM
CONV_W = 256
CONV_K = 3
MLSTM_HEADS = 4
MLSTM_W = MLSTM_HEADS * HEAD_DIM
MLSTM_CHUNK = 64
SWA_Q_HEADS = 8
SWA_KV_HEADS = 2
SWA_W = SWA_Q_HEADS * HEAD_DIM
SWA_KV_W = SWA_KV_HEADS * HEAD_DIM
WINDOW = 128
Q_BLOCK = 128
REL_BUCKETS = 32
REL_MAX_DIST = 128
N_BRANCH = 4
D_FF = -(-8 * D_MODEL // (3 * 256)) * 256
EPS = 1e-6

SPLIT_SIZES = (FOX_W, FOX_W, FOX_W, FOX_HEADS,
               CONV_W, CONV_W, CONV_W,
               MLSTM_W, MLSTM_W, MLSTM_W, MLSTM_HEADS, MLSTM_HEADS, MLSTM_W,
               SWA_W, SWA_KV_W, SWA_KV_W,
               N_BRANCH * D_MODEL)
IN_COLS = sum(SPLIT_SIZES)

kernel_name = 'hybrid_fox_conv_mlstm_swa_block'


def rms_norm(x, gain):
    xf = x.astype(jnp.float32)
    y = xf * lax.rsqrt(jnp.mean(xf * xf, axis=-1, keepdims=True) + EPS)
    return (y * gain.astype(jnp.float32)).astype(x.dtype)


def t5_bucket(n):
    max_exact = REL_BUCKETS // 2
    nf = jnp.maximum(n, 1).astype(jnp.float32)
    large = max_exact + (jnp.log(nf / max_exact) / math.log(REL_MAX_DIST / max_exact)
                         * (REL_BUCKETS - max_exact)).astype(jnp.int32)
    large = jnp.minimum(large, REL_BUCKETS - 1)
    return jnp.where(n < max_exact, n, large)


def fox_attention(q, k, v, f_logit):
    B, S, H, d = q.shape
    nblk = S // Q_BLOCK
    c = jnp.cumsum(jax.nn.log_sigmoid(f_logit.astype(jnp.float32)), axis=1)
    c_t = c.transpose(0, 2, 1)
    qb = q.reshape(B, nblk, Q_BLOCK, H, d).transpose(1, 0, 2, 3, 4)
    cb = c.reshape(B, nblk, Q_BLOCK, H).transpose(1, 0, 3, 2)
    key_pos = jnp.arange(S)
    scale = d ** -0.5

    def block(args):
        qi, ci, bi = args
        s = jnp.einsum('bqhd,bkhd->bhqk', qi, k).astype(jnp.float32) * scale
        s = s + (ci[..., :, None] - c_t[..., None, :])
        q_pos = bi * Q_BLOCK + jnp.arange(Q_BLOCK)
        s = jnp.where(key_pos[None, :] <= q_pos[:, None], s, -jnp.inf)
        p = jax.nn.softmax(s, axis=-1).astype(v.dtype)
        return jnp.einsum('bhqk,bkhd->bqhd', p, v)

    out = lax.map(block, (qb, cb, jnp.arange(nblk)))
    return out.transpose(1, 0, 2, 3, 4).reshape(B, S, H * d)


def short_conv_mixer(u, b_gate, c_gate, w):
    z = c_gate * u
    y = lax.conv_general_dilated(z, w[:, None, :], window_strides=(1,),
                                 padding=[(CONV_K - 1, 0)],
                                 dimension_numbers=('NWC', 'WIO', 'NWC'),
                                 feature_group_count=z.shape[-1])
    return b_gate * y


def mlstm_chunkwise(q, k, v, i_pre, f_pre):
    out_dtype = q.dtype
    f32 = jnp.float32
    B, S, H, d = q.shape
    L = MLSTM_CHUNK
    nc = S // L
    q = q.astype(f32).reshape(B, nc, L, H, d) * d ** -0.5
    k = k.astype(f32).reshape(B, nc, L, H, d)
    v = v.astype(f32).reshape(B, nc, L, H, d)
    log_i = i_pre.astype(f32).reshape(B, nc, L, H)
    log_f = jax.nn.log_sigmoid(f_pre.astype(f32)).reshape(B, nc, L, H)
    b = jnp.cumsum(log_f, axis=2)
    b_last = b[:, :, -1]

    a = b_last[:, :, None] - b + log_i
    m_loc = a.max(axis=2)
    w_state = jnp.exp(a - m_loc[:, :, None])
    c_loc = jnp.einsum('bclh,bclhd,bclhe->bchde', w_state, k, v)
    n_loc = jnp.einsum('bclh,bclhd->bchd', w_state, k)

    def step(carry, xs):
        c_st, n_st, m_st = carry
        bl, ml, cl, nl = xs
        m_new = jnp.maximum(bl + m_st, ml)
        decay = jnp.exp(bl + m_st - m_new)
        wl = jnp.exp(ml - m_new)
        c_new = decay[..., None, None] * c_st + wl[..., None, None] * cl
        n_new = decay[..., None] * n_st + wl[..., None] * nl
        return (c_new, n_new, m_new), (c_st, n_st, m_st)

    init = (jnp.zeros((B, H, d, d), f32), jnp.zeros((B, H, d), f32), jnp.zeros((B, H), f32))
    xs = (jnp.moveaxis(b_last, 1, 0), jnp.moveaxis(m_loc, 1, 0),
          jnp.moveaxis(c_loc, 1, 0), jnp.moveaxis(n_loc, 1, 0))
    _, (c_prev, n_prev, m_prev) = lax.scan(step, init, xs)
    c_prev = jnp.moveaxis(c_prev, 0, 1)
    n_prev = jnp.moveaxis(n_prev, 0, 1)
    m_prev = jnp.moveaxis(m_prev, 0, 1)

    g = b + m_prev[:, :, None, :]
    dmat = b[:, :, :, None, :] - b[:, :, None, :, :] + log_i[:, :, None, :, :]
    causal = jnp.tril(jnp.ones((L, L), dtype=bool))
    dmat = jnp.where(causal[None, None, :, :, None], dmat, -jnp.inf)
    m_t = jnp.maximum(g, dmat.max(axis=3))
    s_w = jnp.einsum('bcthd,bcshd->bctsh', q, k) * jnp.exp(dmat - m_t[:, :, :, None, :])
    inter = jnp.exp(g - m_t)
    num = (jnp.einsum('bctsh,bcshe->bcthe', s_w, v)
           + inter[..., None] * jnp.einsum('bcthd,bchde->bcthe', q, c_prev))
    den = s_w.sum(axis=3) + inter * jnp.einsum('bcthd,bchd->bcth', q, n_prev)
    h = num / jnp.maximum(jnp.abs(den), jnp.exp(-m_t))[..., None]
    return h.reshape(B, S, H, d).astype(out_dtype)


def swa_attention(q, k, v, sinks, bias):
    B, S, Hq, d = q.shape
    Hkv = k.shape[2]
    G = Hq // Hkv
    W = WINDOW
    nb = S // W
    qb = q.reshape(B, nb, W, Hkv, G, d)

    def band(t):
        tp = jnp.pad(t, ((0, 0), (W, 0), (0, 0), (0, 0))).reshape(B, nb + 1, W, Hkv, d)
        return jnp.concatenate([tp[:, :-1], tp[:, 1:]], axis=2)

    kb, vb = band(k), band(v)
    s = jnp.einsum('bnqhgd,bnjhd->bnhgqj', qb, kb).astype(jnp.float32) * d ** -0.5
    s = s + bias.astype(jnp.float32).reshape(Hkv, G, W, 2 * W)
    qi = jnp.arange(W)[:, None]
    kj = jnp.arange(2 * W)[None, :]
    dist = qi + W - kj
    in_window = (dist >= 0) & (dist < WINDOW)
    key_pos = jnp.arange(nb)[:, None, None] * W - W + kj[None]
    valid = in_window[None] & (key_pos >= 0)
    s = jnp.where(valid[None, :, None, None], s, -jnp.inf)
    sink = jnp.broadcast_to(sinks.astype(jnp.float32).reshape(1, 1, Hkv, G, 1, 1),
                            s.shape[:-1] + (1,))
    p = jax.nn.softmax(jnp.concatenate([s, sink], axis=-1), axis=-1)[..., :-1]
    out = jnp.einsum('bnhgqj,bnjhd->bnqhgd', p.astype(v.dtype), vb)
    return out.reshape(B, S, Hq * d)


def setup_inputs(seed: int = 0) -> dict:
    key = jax.random.key(seed)
    ks = jax.random.split(key, 24)

    def nrm(k, shape, scale):
        return jax.random.normal(k, shape, jnp.float32) * scale

    return {
        'x': nrm(ks[0], (BATCH, SEQ, D_MODEL), 1.0),
        'rel_bias': nrm(ks[1], (REL_BUCKETS, SWA_Q_HEADS), 0.5),
        'attn_norm': 1.0 + nrm(ks[2], (DEPTH, D_MODEL), 0.05),
        'w_in': nrm(ks[3], (DEPTH, D_MODEL, IN_COLS), D_MODEL ** -0.5),
        'fox_f_bias': 3.0 + nrm(ks[4], (DEPTH, FOX_HEADS), 1.0),
        'fox_q_gain': 1.0 + nrm(ks[5], (DEPTH, HEAD_DIM), 0.05),
        'fox_k_gain': 1.0 + nrm(ks[6], (DEPTH, HEAD_DIM), 0.05),
        'conv_w': nrm(ks[7], (DEPTH, CONV_K, CONV_W), CONV_K ** -0.5),
        'mlstm_i_bias': nrm(ks[8], (DEPTH, MLSTM_HEADS), 0.1),
        'mlstm_f_bias': 4.0 + nrm(ks[9], (DEPTH, MLSTM_HEADS), 1.0),
        'mlstm_h_gain': 1.0 + nrm(ks[10], (DEPTH, MLSTM_W), 0.05),
        'swa_q_gain': 1.0 + nrm(ks[11], (DEPTH, HEAD_DIM), 0.05),
        'swa_k_gain': 1.0 + nrm(ks[12], (DEPTH, HEAD_DIM), 0.05),
        'swa_sinks': nrm(ks[13], (DEPTH, SWA_Q_HEADS), 1.0),
        'w_fox_out': nrm(ks[14], (DEPTH, FOX_W, D_MODEL), FOX_W ** -0.5),
        'w_conv_out': nrm(ks[15], (DEPTH, CONV_W, D_MODEL), CONV_W ** -0.5),
        'w_mlstm_out': nrm(ks[16], (DEPTH, MLSTM_W, D_MODEL), MLSTM_W ** -0.5),
        'w_swa_out': nrm(ks[17], (DEPTH, SWA_W, D_MODEL), SWA_W ** -0.5),
        'w_merge_out': nrm(ks[18], (DEPTH, D_MODEL, D_MODEL), D_MODEL ** -0.5),
        'ffn_norm': 1.0 + nrm(ks[19], (DEPTH, D_MODEL), 0.05),
        'w_gate': nrm(ks[20], (DEPTH, D_MODEL, D_FF), D_MODEL ** -0.5),
        'w_up': nrm(ks[21], (DEPTH, D_MODEL, D_FF), D_MODEL ** -0.5),
        'w_down': nrm(ks[22], (DEPTH, D_FF, D_MODEL), D_FF ** -0.5),
    }


def reference(x, rel_bias, attn_norm, w_in, fox_f_bias, fox_q_gain, fox_k_gain, conv_w,
              mlstm_i_bias, mlstm_f_bias, mlstm_h_gain, swa_q_gain, swa_k_gain, swa_sinks,
              w_fox_out, w_conv_out, w_mlstm_out, w_swa_out, w_merge_out, ffn_norm,
              w_gate, w_up, w_down):
    B, S, _ = x.shape
    split_points = np.cumsum(SPLIT_SIZES)[:-1].tolist()

    dist = jnp.arange(WINDOW)[:, None] + WINDOW - jnp.arange(2 * WINDOW)[None, :]
    swa_bias = rel_bias[t5_bucket(jnp.maximum(dist, 0))].transpose(2, 0, 1)

    for l in range(DEPTH):
        h = rms_norm(x, attn_norm[l])
        proj = jnp.einsum('bsd,dc->bsc', h, w_in[l])
        (fq, fk, fv, ff, cu, cb, cc, mq, mk, mv, mi, mf, mo, sq, sk, sv,
         gates) = jnp.split(proj, split_points, axis=-1)

        fq = rms_norm(fq.reshape(B, S, FOX_HEADS, HEAD_DIM), fox_q_gain[l])
        fk = rms_norm(fk.reshape(B, S, FOX_HEADS, HEAD_DIM), fox_k_gain[l])
        fv = fv.reshape(B, S, FOX_HEADS, HEAD_DIM)
        y_fox = fox_attention(fq, fk, fv, ff + fox_f_bias[l])

        y_conv = short_conv_mixer(cu, cb, cc, conv_w[l])

        hm = mlstm_chunkwise(mq.reshape(B, S, MLSTM_HEADS, HEAD_DIM),
                             mk.reshape(B, S, MLSTM_HEADS, HEAD_DIM),
                             mv.reshape(B, S, MLSTM_HEADS, HEAD_DIM),
                             mi + mlstm_i_bias[l], mf + mlstm_f_bias[l])
        hm = rms_norm(hm, mlstm_h_gain[l].reshape(MLSTM_HEADS, HEAD_DIM))
        y_mlstm = jax.nn.sigmoid(mo) * hm.reshape(B, S, MLSTM_W)

        sq = rms_norm(sq.reshape(B, S, SWA_Q_HEADS, HEAD_DIM), swa_q_gain[l])
        sk = rms_norm(sk.reshape(B, S, SWA_KV_HEADS, HEAD_DIM), swa_k_gain[l])
        sv = sv.reshape(B, S, SWA_KV_HEADS, HEAD_DIM)
        y_swa = swa_attention(sq, sk, sv, swa_sinks[l], swa_bias)

        g = jax.nn.sigmoid(gates.reshape(B, S, N_BRANCH, D_MODEL))
        merged = (g[:, :, 0] * jnp.einsum('bsw,wd->bsd', y_fox, w_fox_out[l])
                  + g[:, :, 1] * jnp.einsum('bsw,wd->bsd', y_conv, w_conv_out[l])
                  + g[:, :, 2] * jnp.einsum('bsw,wd->bsd', y_mlstm, w_mlstm_out[l])
                  + g[:, :, 3] * jnp.einsum('bsw,wd->bsd', y_swa, w_swa_out[l]))
        x = x + jnp.einsum('bsd,de->bse', merged, w_merge_out[l])

        h = rms_norm(x, ffn_norm[l])
        act = jax.nn.silu(jnp.einsum('bsd,df->bsf', h, w_gate[l])) * jnp.einsum('bsd,df->bsf', h, w_up[l])
        x = x + jnp.einsum('bsf,fd->bsd', act, w_down[l])
    return x
```

```cpp
#include <hip/hip_runtime.h>
#include <cstdio>
#include <cstdint>
#include <hip/hip_bf16.h>
#include <cmath>

typedef unsigned short bf16;
constexpr int BATCH = 16, SEQ = 2048, D = 1024, M = BATCH * SEQ, DEPTH = 2;
constexpr int IN_COLS = 7436, NPROJ = 3328, NMIX = 3584, NIN = 7680, GATE0 = 3584, DFF = 2816, YW = 1280;
constexpr float EPS = 1e-6f, LOG2E = 1.4426950408889634f, C2 = 0.125f * LOG2E;
constexpr size_t MiB = 1u << 20;
constexpr size_t WS_CTL = 0, CTL_ZERO_BYTES = 64 * 1024;
constexpr size_t WS_W = 1 * MiB, W_LAYER = 36 * MiB;
constexpr size_t OFF_WIN = 0, OFF_WBR = 15 * MiB, OFF_WMO = OFF_WBR + 2560 * 1024, OFF_WGU = OFF_WMO + 2 * MiB, OFF_WD = OFF_WGU + 11 * MiB;
constexpr size_t WS_XA = 73 * MiB, WS_XB = 137 * MiB, WS_SMALL = 201 * MiB, WS_SSQ = 203 * MiB, WS_Y = 208 * MiB, WS_PROJ = 288 * MiB, WS_ACT = 288 * MiB, WS_W8 = 496 * MiB, WS_END = 504 * MiB;
constexpr size_t WS_SLAB = WS_PROJ  ;
constexpr size_t OUT_XA8 = 64 * MiB;
constexpr int CW_BAR = 4096;
constexpr int RING_BYTES = 131072, LDSCTL_OFF = RING_BYTES, MISC_OFF = LDSCTL_OFF + 320, LDS_BYTES = 147456;
constexpr int NWAVES = 8;

#define GAS __attribute__((address_space(1)))
#define LAS __attribute__((address_space(3)))
typedef unsigned v4u __attribute__((ext_vector_type(4)));
typedef unsigned v2u __attribute__((ext_vector_type(2)));
typedef float f32x4 __attribute__((ext_vector_type(4)));
typedef short bf16x8 __attribute__((ext_vector_type(8)));
typedef GAS unsigned gu32;

__device__ __forceinline__ float bf2f(bf16 v) { return __uint_as_float((unsigned)v << 16); }
__device__ __forceinline__ float bflo(unsigned w) { return __uint_as_float(w << 16); }
__device__ __forceinline__ float bfhi(unsigned w) { return __uint_as_float(w & 0xffff0000u); }
__device__ __forceinline__ unsigned f2bf(float f) { unsigned u = __float_as_uint(f); return (u + 0x7fffu + ((u >> 16) & 1u)) >> 16; }
typedef float f32x2_g __attribute__((ext_vector_type(2))); typedef __bf16 bf16x2_g __attribute__((ext_vector_type(2)));
__device__ __forceinline__ unsigned pk2(float lo, float hi) { f32x2_g t = {lo, hi}; bf16x2_g b = __builtin_convertvector(t, bf16x2_g); return __builtin_bit_cast(unsigned, b); }
__device__ __forceinline__ unsigned pk4_f8(float a, float b, float c, float d) {
    a = __builtin_fminf(__builtin_fmaxf(a, -448.f), 448.f); b = __builtin_fminf(__builtin_fmaxf(b, -448.f), 448.f); c = __builtin_fminf(__builtin_fmaxf(c, -448.f), 448.f); d = __builtin_fminf(__builtin_fmaxf(d, -448.f), 448.f);
    int w = __builtin_amdgcn_cvt_pk_fp8_f32(a, b, 0, false); w = __builtin_amdgcn_cvt_pk_fp8_f32(c, d, w, true); return (unsigned)w; }
__device__ __forceinline__ float sigmoidf_(float x) { return __builtin_amdgcn_rcpf(1.f + __builtin_amdgcn_exp2f(-LOG2E * x)); }
__device__ __forceinline__ float logsigmoidf_(float x) { return fminf(x, 0.f) - 0.6931471805599453f * __builtin_amdgcn_logf(1.f + __builtin_amdgcn_exp2f(-LOG2E * fabsf(x))); }
constexpr int WTAB_OFF = LDSCTL_OFF + 1024;
extern __shared__ __attribute__((aligned(16))) unsigned char lds_g_[];
__device__ __forceinline__ unsigned hwkey_() { return (unsigned)__builtin_amdgcn_s_getreg((5 << 11) | 4) & 0x3fu; }
__device__ __forceinline__ int ltid() {
    const int wave = __builtin_amdgcn_readfirstlane(((const LAS int*)((LAS unsigned char*)lds_g_ + WTAB_OFF))[hwkey_()]);
    int ln; asm volatile("v_mbcnt_lo_u32_b32 %0, -1, 0\n\tv_mbcnt_hi_u32_b32 %0, -1, %0" : "=&v"(ln));
    int t = wave * 64 + ln; asm volatile("" : "+v"(t)); return t; }
__device__ __forceinline__ float sum_x16(float x) { const auto r = __builtin_amdgcn_permlane16_swap(__float_as_uint(x), __float_as_uint(x), false, false); return __uint_as_float(r[0]) + __uint_as_float(r[1]); }
__device__ __forceinline__ float sum_x32(float x) { const auto r = __builtin_amdgcn_permlane32_swap(__float_as_uint(x), __float_as_uint(x), false, false); return __uint_as_float(r[0]) + __uint_as_float(r[1]); }
__device__ __forceinline__ float max_x16(float x) { const auto r = __builtin_amdgcn_permlane16_swap(__float_as_uint(x), __float_as_uint(x), false, false); return fmaxf(__uint_as_float(r[0]), __uint_as_float(r[1])); }
__device__ __forceinline__ float max_x32(float x) { const auto r = __builtin_amdgcn_permlane32_swap(__float_as_uint(x), __float_as_uint(x), false, false); return fmaxf(__uint_as_float(r[0]), __uint_as_float(r[1])); }
__device__ __forceinline__ float sum_fq(float x) { return sum_x32(sum_x16(x)); }
__device__ __forceinline__ float max_fq(float x) { return max_x32(max_x16(x)); }
__device__ __forceinline__ float lane_get(float x, int src_lane) { return __int_as_float(__builtin_amdgcn_ds_bpermute(src_lane << 2, __float_as_int(x))); }
__device__ __forceinline__ float rstd_of(const float* ssq, int row) {
    const f32x4 a = *(const f32x4*)(ssq + (size_t)row * 4);
    return rsqrtf(((a.x + a.y) + (a.z + a.w)) * (1.f / D) + EPS);
}
constexpr int RED_OFF = LDSCTL_OFF + 4096;

namespace pg8 {
#define PG8_LAS __attribute__((address_space(3)))
typedef unsigned short bf16_t;
typedef short bf16x8 __attribute__((ext_vector_type(8)));
typedef float f32x4 __attribute__((ext_vector_type(4)));
typedef unsigned u32x4 __attribute__((ext_vector_type(4)));
typedef int v4i32_ __attribute__((ext_vector_type(4))); typedef int v8i32_ __attribute__((ext_vector_type(8)));
constexpr int BM = 256, BK = 64, HALF = 128, HTB = HALF * BK * 2  , STAGE_BYTES = 8 * HTB, NXCD = 8, WGM = 2;

__host__ __device__ __forceinline__ int lds_byte(int r, int c) { const int st = (r >> 4) * 2 + (c >> 5), rr = r & 15, cc = c & 31, ob = rr * 64 + cc * 2; return st * 1024 + (ob ^ (((ob >> 9) & 1) << 5)); }
__host__ __device__ __forceinline__ void stage_rc(int b, int& R, int& C) { const int st = b / 1024, sb = b % 1024, swz = sb ^ (((sb >> 9) & 1) << 5); R = (st >> 1) * 16 + swz / 64; C = (st & 1) * 32 + (swz % 64) / 2; }
__host__ __device__ __forceinline__ int perm32(int rho) { const int n = rho >> 4, i = rho & 15; return 8 * (i >> 2) + 4 * n + (i & 3); }

struct Unit { int pm, pn; };

struct StaticOrder {
    int nM, nN, nwg, G, c;
    __host__ __device__ void init(int M, int N, int G_, int c_) { nM = M / BM; nN = N / BM; nwg = nM * nN; G = G_; c = c_; }
    __host__ __device__ bool next(int i, Unit& u) const {
        const long L = (long)i * G + c; if (L >= nwg) return false;
        int wgid = (int)L; { const int q = nwg / NXCD, r = nwg % NXCD, xcd = wgid % NXCD, off = wgid / NXCD; wgid = (xcd < r ? xcd * (q + 1) : r * (q + 1) + (xcd - r) * q) + off; }
        const int nig = WGM * nN, gid = wgid / nig, fm = gid * WGM, gsz = (nM - fm) < WGM ? (nM - fm) : WGM;
        u.pm = fm + ((wgid % nig) % gsz); u.pn = (wgid % nig) / gsz; return true;
    }
    __device__ __forceinline__ void a_ready(const Unit&) const {}
    __device__ __forceinline__ void done(const Unit&) const {}
};
struct Gemm { const bf16_t* A; const bf16_t* Bt; int M, N, K, lda, ldb; };
typedef float f32x2_t __attribute__((ext_vector_type(2))); typedef __bf16 bf16x2_t __attribute__((ext_vector_type(2)));
__device__ __forceinline__ unsigned cvt_pk_bf16(float lo, float hi) { f32x2_t v = {lo, hi}; bf16x2_t b = __builtin_convertvector(v, bf16x2_t); return __builtin_bit_cast(unsigned, b); }
__device__ __forceinline__ u32x4 pack8(const f32x4 a, const f32x4 b) { u32x4 w; w.x = cvt_pk_bf16(a[0], a[1]); w.y = cvt_pk_bf16(a[2], a[3]); w.z = cvt_pk_bf16(b[0], b[1]); w.w = cvt_pk_bf16(b[2], b[3]); return w; }

struct RowPf { };
constexpr int RT_OFF = LDSCTL_OFF + 8192, RED_OFF_ = LDSCTL_OFF + 4096;
__device__ __forceinline__ void pf_rows(RowPf&, const float* ssq, const Unit& u, int wr, int fr, int tid) {
    if (wr == 0) { const int wq = __builtin_amdgcn_readfirstlane(tid >> 6);
        __builtin_amdgcn_global_load_lds((const unsigned*)(ssq + (size_t)(u.pm * BM + tid) * 4), (PG8_LAS unsigned*)((PG8_LAS unsigned char*)lds_g_ + RED_OFF_ + wq * 1024), 16, 0, 0); } }
__device__ __forceinline__ void pf_publish(const RowPf& pf, int tid) {
    PG8_LAS float* RT = (PG8_LAS float*)((PG8_LAS unsigned char*)lds_g_ + RT_OFF);
    asm volatile("s_waitcnt vmcnt(16)" ::: "memory");
    if (tid < BM) { const f32x4 v = *(const PG8_LAS f32x4*)((PG8_LAS unsigned char*)lds_g_ + RED_OFF_ + tid * 16); RT[tid] = rsqrtf(((v.x + v.y) + (v.z + v.w)) * (1.f / D) + EPS); }
    asm volatile("s_waitcnt lgkmcnt(0)" ::: "memory"); __builtin_amdgcn_s_barrier(); asm volatile("" ::: "memory");
}
__device__ __forceinline__ float pf_rstd(int ai, int wr, int m, int fr) { return ((const PG8_LAS float*)((PG8_LAS unsigned char*)lds_g_ + RT_OFF))[ai * HALF + wr * 64 + m * 16 + fr]; }

struct EpiP1 {
    static constexpr bool AFTER_DRAIN = false;
    bf16_t* proj; float* small; const float* ssq; const float *fqg, *fkg, *sqg, *skg;
    __device__ __forceinline__ void prefetch(RowPf& pf, const Unit& u, int wr, int fr, int tid) const { pf_rows(pf, ssq, u, wr, fr, tid); }
    __device__ __forceinline__ void operator()(const f32x4 (&acc)[2][2][4][2], const Unit& u, int wr, int wc, int fr, int fq, const RowPf& pf) const {
        pf_publish(pf, (wr * 4 + wc) * 64 + fq * 16 + fr);
        const int pn = u.pn; const float* gain = nullptr; float sc = 1.f;
        if (pn == 0) { gain = fqg; sc = C2; } else if (pn == 1) gain = fkg; else if (pn == 10 || pn == 11) { gain = sqg; sc = C2; } else if (pn == 12 && wc < 2) gain = skg;
        f32x4 gv[2][2];
#pragma unroll
        for (int bj = 0; bj < 2; ++bj)
#pragma unroll
            for (int n = 0; n < 2; ++n) gv[bj][n] = gain ? *(const f32x4*)(gain + 32 * bj + 8 * fq + 4 * n) : (f32x4){1.f, 1.f, 1.f, 1.f};
#pragma unroll
        for (int ai = 0; ai < 2; ++ai)
#pragma unroll
            for (int m = 0; m < 4; ++m) {
                const int row = u.pm * BM + ai * HALF + wr * 64 + m * 16 + fr; const float r = pf_rstd(ai, wr, m, fr);
                f32x4 v[2][2];
#pragma unroll
                for (int bj = 0; bj < 2; ++bj)
#pragma unroll
                    for (int n = 0; n < 2; ++n) v[bj][n] = acc[ai][bj][m][n] * r;
                if (gain) {
                    float ss = 0.f;
#pragma unroll
                    for (int bj = 0; bj < 2; ++bj)
#pragma unroll
                        for (int n = 0; n < 2; ++n) { const f32x4 x = v[bj][n]; ss += (x[0] * x[0] + x[1] * x[1]) + (x[2] * x[2] + x[3] * x[3]); }
                    ss = sum_fq(ss);
                    const float rinv = rsqrtf(ss * (1.f / 64.f) + EPS) * sc;
#pragma unroll
                    for (int bj = 0; bj < 2; ++bj)
#pragma unroll
                        for (int n = 0; n < 2; ++n) v[bj][n] = v[bj][n] * rinv * gv[bj][n];
                }
                if (pn == 13) {
                    if (wc == 0) { if (fq == 0) { *(f32x4*)(small + (size_t)row * 16) = v[0][0]; *(f32x4*)(small + (size_t)row * 16 + 4) = v[0][1]; } else if (fq == 1) *(f32x4*)(small + (size_t)row * 16 + 8) = v[0][0]; }
                } else {
                    bf16_t* o = proj + (size_t)row * NPROJ + pn * BM + wc * 64 + 8 * fq;
                    *(u32x4*)(o) = pack8(v[0][0], v[0][1]); *(u32x4*)(o + 32) = pack8(v[1][0], v[1][1]);
                }
            }
    }
};
struct FourUnit { int pm, pp; __device__ __forceinline__ bool next(int i, Unit& o) const { if (i > 3) return false; o.pm = pm; o.pn = 4 * pp + i; return true; } __device__ __forceinline__ void a_ready(const Unit&) const {} __device__ __forceinline__ void done(const Unit&) const {} };
struct EpiGateS {
    static constexpr bool AFTER_DRAIN = false;
    u32x4* slab; const float* ssq;
    __device__ __forceinline__ void prefetch(RowPf&, const Unit&, int, int, int) const {}
    __device__ __forceinline__ void operator()(const f32x4 (&acc)[2][2][4][2], const Unit& u, int, int, int, int, const RowPf&) const {
        typedef unsigned u32x2 __attribute__((ext_vector_type(2)));
        const int t_ = ltid(), wid_ = __builtin_amdgcn_readfirstlane(t_ >> 6), wr = wid_ >> 2, wc = wid_ & 3, fr = t_ & 15, fq = (t_ >> 4) & 3;
        unsigned vo = (unsigned)((wr * 4 + wc) * 8192 + (fq * 16 + fr) * 16); asm volatile("" : "+v"(vo));
        unsigned char* sb = (unsigned char*)(slab + (u.pn & 3) * 128);
        float rr[2][4];
#pragma unroll
        for (int ai = 0; ai < 2; ++ai)
#pragma unroll
            for (int m = 0; m < 4; ++m) rr[ai][m] = pf_rstd(ai, wr, m, fr);
#pragma unroll
        for (int ai = 0; ai < 2; ++ai)
#pragma unroll
            for (int m = 0; m < 4; ++m) {
                f32x4 d[4];
#pragma unroll
                for (int s = 0; s < 4; ++s) { const f32x4 xs = acc[ai][s >> 1][m][s & 1] * rr[ai][m];
#pragma unroll
                    for (int e = 0; e < 4; ++e) d[s][e] = 1.f + __builtin_amdgcn_exp2f(fminf(fmaxf(xs[e], -43.28f), 43.28f)); }
#pragma unroll
                for (int s = 0; s < 4; ++s) { f32x4 q;
#pragma unroll
                    for (int e = 0; e < 4; ++e) { const float iv = __builtin_amdgcn_rcpf(d[s][e]); q[e] = s < 3 ? d[s < 3 ? s + 1 : 3][e] * iv : iv; }
                    u32x2 w; w.x = cvt_pk_bf16(q[0], q[1]); w.y = cvt_pk_bf16(q[2], q[3]);
                    *(u32x2*)(sb + (size_t)((s * 2 + ai) * 65536 + (m >> 1) * 1024 + (m & 1) * 8) + vo) = w; }
                asm volatile("" ::: "memory"); __builtin_amdgcn_sched_barrier(0); }
    }
};
template <bool NOB = false>
__device__ __forceinline__ void merge_gemm(PG8_LAS unsigned char* lds, const int pm, const int pn, const bf16_t* y, const bf16_t* wbr, bf16_t* xb, const u32x4* slab) {
    const int tid_ = ltid();
    const int tid = tid_, wid = __builtin_amdgcn_readfirstlane(tid >> 6), lane = tid & 63, wr = wid >> 2, wc = wid & 3, fr = lane & 15, fq = lane >> 4;
    constexpr int nt = YW / BK;
    unsigned voffA[2], voffB[2];
#pragma unroll
    for (int i = 0; i < 2; ++i) { int R, C; stage_rc(tid * 16 + i * 8192, R, C); const int Rb = 64 * ((R >> 4) & 1) + 16 * (R >> 5) + (R & 15);
        voffA[i] = (unsigned)(R * YW + C) * 2u; voffB[i] = (unsigned)(Rb * YW + C) * 2u; }
    constexpr int kstep = BK * 2, hstepA = HALF * YW * 2, hstepB = 128 * YW * 2;
    const unsigned ldsw = (unsigned)wid * 1024u;
    const int aoff = lds_byte(wr * 64 + fr, fq * 8), boff = lds_byte(wc * 32 + fr, fq * 8);
    const __amdgpu_buffer_rsrc_t rsA = __builtin_amdgcn_make_buffer_rsrc((void*)(y + (size_t)pm * BM * YW), (short)0, BM * YW * 2, 0x00020000);
    const __amdgpu_buffer_rsrc_t rsB = __builtin_amdgcn_make_buffer_rsrc((void*)(wbr + (size_t)pn * BM * YW), (short)0, BM * YW * 2, 0x00020000);
#define MG_SA(b, h) (((b) * 2 + (h)) * HTB)
#define MG_SB(b, h) ((4 + (b) * 2 + (h)) * HTB)
#define MG_STAGE(bufoff, rs, soff, voff) do { _Pragma("unroll") for (int _i = 0; _i < 2; ++_i) \
        __builtin_amdgcn_raw_ptr_buffer_load_lds(rs, (PG8_LAS void*)(lds + (bufoff) + ldsw + _i * 8192), 16, (int)(voff)[_i], (int)(soff), 0, 0); } while (0)
#define MG_LDA(dst, b, h) do { _Pragma("unroll") for (int m = 0; m < 4; ++m) _Pragma("unroll") for (int k = 0; k < 2; ++k) dst[m][k] = *(const PG8_LAS bf16x8*)(lds + MG_SA(b, h) + aoff + m * 2048 + k * 1024); } while (0)
#define MG_LDB(dst, b, h) do { _Pragma("unroll") for (int n = 0; n < 2; ++n) _Pragma("unroll") for (int k = 0; k < 2; ++k) dst[n][k] = *(const PG8_LAS bf16x8*)(lds + MG_SB(b, h) + boff + n * 2048 + k * 1024); } while (0)
#define MG_MMA(ai, bj, At, Bt) do { __builtin_amdgcn_s_setprio(1); \
        _Pragma("unroll") for (int m = 0; m < 4; ++m) _Pragma("unroll") for (int n = 0; n < 2; ++n) _Pragma("unroll") for (int k = 0; k < 2; ++k) \
            acc[ai][bj][m][n] = __builtin_amdgcn_mfma_f32_16x16x32_bf16(Bt[n][k], At[m][k], acc[ai][bj][m][n], 0, 0, 0); \
        __builtin_amdgcn_s_setprio(0); } while (0)
#define MG_WAIT_V(n) asm volatile("s_waitcnt vmcnt(" #n ")" ::: "memory")
#define MG_WAIT_L(n) asm volatile("s_waitcnt lgkmcnt(" #n ")" ::: "memory")
#define MG_BAR __builtin_amdgcn_s_barrier()
#define MG_SCHED __builtin_amdgcn_sched_barrier(0)
#define MG_LOADR(ai, R) do { const int ro_ = (int)(((ai) * 8 + wid) * 8192) + lo_; \
        _Pragma("unroll") for (int j = 0; j < 8; ++j) R[j] = __builtin_bit_cast(u32x4, __builtin_amdgcn_raw_buffer_load_b128(rsS, ro_ + (j & 3) * 1024, (j >> 2) * 4096, 0)); } while (0)
#define MG_SCALE(ai, R) do { _Pragma("unroll") for (int bj = 0; bj < 2; ++bj) _Pragma("unroll") for (int n = 0; n < 2; ++n) _Pragma("unroll") for (int mh = 0; mh < 2; ++mh) { const u32x4 q = R[2 * (2 * bj + n) + mh]; \
        acc[ai][bj][2 * mh][n] *= (f32x4){bflo(q.x), bfhi(q.x), bflo(q.y), bfhi(q.y)}; acc[ai][bj][2 * mh + 1][n] *= (f32x4){bflo(q.z), bfhi(q.z), bflo(q.w), bfhi(q.w)}; MG_SCHED; } } while (0)
#define MG_BOUNDARY(plane) do { const __amdgpu_buffer_rsrc_t rsS = __builtin_amdgcn_make_buffer_rsrc((void*)(slab + (size_t)((plane) * 8192)), (short)0, 131072, 0x00020000); \
        const int tb_ = ltid(); const int lo_ = (tb_ & 63) * 16; u32x4 R0[8], R1[8];        MG_LOADR(0, R0); MG_LOADR(1, R1); MG_SCALE(0, R0); MG_SCALE(1, R1); MG_SCHED; } while (0)
#define MG_ITER(T, LAST) do { const int a1 = ((T) + 1) * kstep, a2 = (LAST) ? 0 : ((T) + 2) * kstep, a3 = a2 + kstep; \
        MG_LDB(B0, 0, 0); MG_LDB(B1, 0, 1); MG_SCHED; MG_LDA(At, 0, 0); MG_STAGE(MG_SA(1, 1), rsA, a1 + hstepA, voffA); \
        MG_WAIT_V(8); MG_WAIT_L(0); MG_BAR; MG_MMA(0, 0, At, B0); MG_MMA(0, 1, At, B1); MG_BAR; MG_SCHED; \
        MG_LDA(At, 0, 1); MG_STAGE(MG_SB(0, 0), rsB, a2, voffB); MG_STAGE(MG_SB(0, 1), rsB, a2 + hstepB, voffB); MG_STAGE(MG_SA(0, 0), rsA, a2, voffA); \
        MG_WAIT_V(8); MG_WAIT_L(0); MG_BAR; MG_MMA(1, 0, At, B0); MG_MMA(1, 1, At, B1); MG_BAR; MG_SCHED; \
        MG_LDB(B0, 1, 0); MG_LDB(B1, 1, 1); MG_SCHED; MG_LDA(At, 1, 0); MG_STAGE(MG_SA(0, 1), rsA, a2 + hstepA, voffA); \
        MG_WAIT_V(8); MG_WAIT_L(0); MG_BAR; MG_MMA(0, 0, At, B0); MG_MMA(0, 1, At, B1); MG_BAR; MG_SCHED; \
        MG_LDA(At, 1, 1); MG_STAGE(MG_SB(1, 0), rsB, a3, voffB); MG_STAGE(MG_SB(1, 1), rsB, a3 + hstepB, voffB); MG_STAGE(MG_SA(1, 0), rsA, a3, voffA); \
        MG_WAIT_V(8); MG_WAIT_L(0); MG_BAR; MG_MMA(1, 0, At, B0); MG_MMA(1, 1, At, B1); MG_BAR; MG_SCHED; } while (0)
    float z0_; asm volatile("v_mov_b32 %0, 0" : "=v"(z0_));
    f32x4 acc[2][2][4][2];
#pragma unroll
    for (int a = 0; a < 2; ++a)
#pragma unroll
        for (int b = 0; b < 2; ++b)
#pragma unroll
            for (int m = 0; m < 4; ++m)
#pragma unroll
                for (int n = 0; n < 2; ++n) acc[a][b][m][n] = (f32x4){z0_, z0_, z0_, z0_};
    bf16x8 At[4][2], B0[2][2], B1[2][2];
    MG_WAIT_V(0);
    MG_STAGE(MG_SB(0, 0), rsB, 0, voffB); MG_STAGE(MG_SB(0, 1), rsB, hstepB, voffB); MG_STAGE(MG_SA(0, 0), rsA, 0, voffA); MG_STAGE(MG_SA(0, 1), rsA, hstepA, voffA);
    if (wr == 1) MG_BAR;
    MG_WAIT_V(2); MG_BAR;
    MG_STAGE(MG_SB(1, 0), rsB, kstep, voffB); MG_STAGE(MG_SA(1, 0), rsA, kstep, voffA); MG_STAGE(MG_SB(1, 1), rsB, hstepB + kstep, voffB);
    MG_WAIT_V(6); MG_BAR;
#pragma unroll 1
    for (int t = 0; t < 12; t += 4) { MG_ITER(t, false); MG_ITER(t + 2, false); if constexpr (!NOB) MG_BOUNDARY(t >> 2); }
#pragma unroll 1
    for (int t = 12; t < nt; t += 2) MG_ITER(t, t == nt - 2);
    if (wr == 0) MG_BAR;
    {   typedef unsigned u32x2 __attribute__((ext_vector_type(2)));
        const __amdgpu_buffer_rsrc_t rsS = __builtin_amdgcn_make_buffer_rsrc((void*)(slab + (size_t)(3 * 8192)), (short)0, 131072, 0x00020000);
        const __amdgpu_buffer_rsrc_t rsO = __builtin_amdgcn_make_buffer_rsrc((void*)(xb + (size_t)pm * BM * D + pn * 256), (short)0, BM * D * 2, 0x00020000);
        const int t2_ = ltid(), w2_ = __builtin_amdgcn_readfirstlane(t2_ >> 6);
        const int lo_ = (t2_ & 63) * 16; const int ob = (((w2_ >> 2) * 64 + (t2_ & 15)) * D + (w2_ & 3) * 16 + ((t2_ >> 4) & 3) * 4) * 2;
        u32x4 R0[8], R1[8]; if constexpr (!NOB) { MG_LOADR(0, R0); MG_LOADR(1, R1); } MG_SCHED;
#define MG_OUT(ai, R) do { if constexpr (!NOB) MG_SCALE(ai, R); _Pragma("unroll") for (int m = 0; m < 4; ++m) _Pragma("unroll") for (int bj = 0; bj < 2; ++bj) _Pragma("unroll") for (int n = 0; n < 2; ++n) { \
            const f32x4 v = acc[ai][bj][m][n]; u32x2 w; w.x = cvt_pk_bf16(v[0], v[1]); w.y = cvt_pk_bf16(v[2], v[3]); \
            __builtin_amdgcn_raw_buffer_store_b64(w, rsO, ob, (((ai) * HALF + m * 16) * D + 64 * (2 * bj + n)) * 2, 0); MG_SCHED; } } while (0)
        MG_OUT(0, R0); MG_OUT(1, R1);
#undef MG_OUT
    }
    MG_WAIT_V(0);
    MG_BAR;
#undef MG_ITER
#undef MG_BOUNDARY
#undef MG_SA
#undef MG_SB
#undef MG_STAGE
#undef MG_LDA
#undef MG_LDB
#undef MG_MMA
#undef MG_WAIT_V
#undef MG_WAIT_L
#undef MG_BAR
#undef MG_SCHED
#undef MG_LOADR
#undef MG_SCALE
}

struct EpiRes {
    static constexpr bool AFTER_DRAIN = false;
    bf16_t* xa; float* out32; float* ssq; unsigned char* xa8;
    __device__ __forceinline__ void prefetch(RowPf&, const Unit&, int, int, int) const {}
    __device__ __forceinline__ void operator()(const f32x4 (&acc)[2][2][4][2], const Unit& u, int wr, int wc, int fr, int fq, const RowPf&) const {
        const int vo = (u.pm * BM + wr * 64 + fr) * D + u.pn * BM + wc * 64 + 8 * fq;
        u32x4 rb[2][4][2];
#pragma unroll
        for (int ai = 0; ai < 2; ++ai)
#pragma unroll
            for (int m = 0; m < 4; ++m)
#pragma unroll
                for (int bj = 0; bj < 2; ++bj) rb[ai][m][bj] = *(const u32x4*)(xa + (size_t)vo + (ai * HALF + m * 16) * D + 32 * bj);
        __builtin_amdgcn_sched_barrier(0);
#pragma unroll
        for (int ai = 0; ai < 2; ++ai) {
#pragma unroll
            for (int m = 0; m < 4; ++m) {
                const int so = (ai * HALF + m * 16) * D; float ss = 0.f;
#pragma unroll
                for (int bj = 0; bj < 2; ++bj) {
                    const u32x4 w = rb[ai][m][bj]; f32x4 a = (f32x4){bflo(w.x), bfhi(w.x), bflo(w.y), bfhi(w.y)}, b = (f32x4){bflo(w.z), bfhi(w.z), bflo(w.w), bfhi(w.w)};
                    a = a + acc[ai][bj][m][0]; b = b + acc[ai][bj][m][1];
                    if (out32) { *(f32x4*)(out32 + (size_t)vo + so + 32 * bj) = a; *(f32x4*)(out32 + (size_t)vo + so + 32 * bj + 4) = b; }
                    else *(u32x4*)(xa + (size_t)vo + so + 32 * bj) = pack8(a, b);
                    if (xa8) { typedef unsigned u32x2 __attribute__((ext_vector_type(2))); u32x2 w8; w8.x = pk4_f8(a[0], a[1], a[2], a[3]); w8.y = pk4_f8(b[0], b[1], b[2], b[3]);
                        *(u32x2*)(xa8 + (size_t)vo + so + 32 * bj) = w8; }
                    ss += ((a[0] * a[0] + a[1] * a[1]) + (a[2] * a[2] + a[3] * a[3])) + ((b[0] * b[0] + b[1] * b[1]) + (b[2] * b[2] + b[3] * b[3]));
                }
                if (ssq) { ss = sum_fq(ss); if (fq == 0) ((PG8_LAS float*)((PG8_LAS unsigned char*)lds_g_ + RED_OFF))[(ai * HALF + wr * 64 + m * 16 + fr) * 4 + wc] = ss; }
            }
        }
        if (ssq) {
            asm volatile("s_waitcnt lgkmcnt(0)" ::: "memory"); __builtin_amdgcn_s_barrier(); asm volatile("" ::: "memory");
            const int t = (wr * 4 + wc) * 64 + fq * 16 + fr;
            if (t < BM) { const f32x4 p = *(const PG8_LAS f32x4*)((PG8_LAS unsigned char*)lds_g_ + RED_OFF + t * 16); ssq[(size_t)(u.pm * BM + t) * 4 + u.pn] = (p.x + p.y) + (p.z + p.w); }
        }
    }
};
struct EpiFFN {
    static constexpr bool AFTER_DRAIN = false;
    bf16_t* act; const float* ssq;
    __device__ __forceinline__ void prefetch(RowPf& pf, const Unit& u, int wr, int fr, int tid) const { pf_rows(pf, ssq, u, wr, fr, tid); }
    __device__ __forceinline__ void operator()(const f32x4 (&acc)[2][2][4][2], const Unit& u, int wr, int wc, int fr, int fq, const RowPf& pf) const {
        pf_publish(pf, (wr * 4 + wc) * 64 + fq * 16 + fr);
#pragma unroll
        for (int ai = 0; ai < 2; ++ai)
#pragma unroll
            for (int m = 0; m < 4; ++m) {
                const int row = u.pm * BM + ai * HALF + wr * 64 + m * 16 + fr; const float r = pf_rstd(ai, wr, m, fr);
                f32x4 o[2];
#pragma unroll
                for (int n = 0; n < 2; ++n) { const f32x4 gt = acc[ai][0][m][n] * r, up = acc[ai][1][m][n] * r;
#pragma unroll
                    for (int e = 0; e < 4; ++e) o[n][e] = gt[e] * sigmoidf_(gt[e]) * up[e]; }
                *(u32x4*)(act + (size_t)row * DFF + u.pn * 128 + wc * 32 + 8 * fq) = pack8(o[0], o[1]);
            }
    }
};

template <class Epi, class Sched, bool ALIGN_EPI = false, bool SP2 = false, int BMODE = 0, bool F8 = false>
__device__ __forceinline__ void gemm_phase(PG8_LAS unsigned char* lds, const Gemm g, const Sched& S, const Epi& E) {
    const int tid_ = ltid();
    const int tid = tid_, wid = __builtin_amdgcn_readfirstlane(tid >> 6), lane = tid & 63, wr = wid >> 2, wc = wid & 3, fr = lane & 15, fq = lane >> 4;
    const int K = g.K, nt = K / BK;
    unsigned voffA[2], voffB[2];
#pragma unroll
    for (int i = 0; i < 2; ++i) { int R, C; stage_rc(tid * 16 + i * 8192, R, C); const int Rb = BMODE == 0 ? 64 * (R >> 5) + perm32(R & 31)
                                         : 1024 * ((R >> 4) & 1) + 16 * (R >> 5) + (R & 15);
        voffA[i] = (unsigned)(R * g.lda + C) * 2u; voffB[i] = (unsigned)(Rb * g.ldb + C) * 2u; }
    const size_t kstep = (size_t)(BK * 2);
    const size_t hstepA = (size_t)HALF * g.lda * 2, hstepB = (size_t)(BMODE == 0 ? 32 : 2048) * g.ldb * 2;
    const size_t tstepA = (size_t)BM * g.lda * 2, tstepB = (size_t)(BMODE == 0 ? BM : 64) * g.ldb * 2;
    const unsigned ldsw = (unsigned)wid * 1024u;
    const int aoff = lds_byte(wr * 64 + fr, fq * 8), boff = lds_byte(wc * 32 + fr, fq * 8);
#define PG8_SA(b, h) (((b) * 2 + (h)) * HTB)
#define PG8_SB(b, h) ((4 + (b) * 2 + (h)) * HTB)
#define PG8_STAGE(bufoff, gbase, voff) do { _Pragma("unroll") for (int _i = 0; _i < 2; ++_i) { \
        if constexpr (F8) { unsigned keep_; const char* sb_ = (const char*)(gbase); const unsigned ld_ = (unsigned)(size_t)(lds + (bufoff) + ldsw + _i * 8192); \
            asm volatile("s_mov_b32 %0, m0\n\ts_mov_b32 m0, %3\n\ts_nop 0\n\tglobal_load_lds_dwordx4 %1, %2\n\ts_mov_b32 m0, %0" : "=&s"(keep_) : "v"((voff)[_i]), "s"(sb_), "s"(ld_) : "memory"); } \
        else __builtin_amdgcn_global_load_lds((const unsigned*)((const char*)(gbase) + (voff)[_i]), (PG8_LAS unsigned*)(lds + (bufoff) + ldsw + _i * 8192), 16, 0, 0); } } while (0)
#define PG8_LDA(dst, b, h) do { if constexpr (F8) { _Pragma("unroll") for (int m = 0; m < 4; ++m) { const v4i32_ lo_ = *(const PG8_LAS v4i32_*)(lds + PG8_SA(b, h) + aoff + m * 2048), hi_ = *(const PG8_LAS v4i32_*)(lds + PG8_SA(b, h) + aoff + m * 2048 + 1024); dst##8[m] = __builtin_shufflevector(lo_, hi_, 0, 1, 2, 3, 4, 5, 6, 7); } } \
        else { _Pragma("unroll") for (int m = 0; m < 4; ++m) _Pragma("unroll") for (int k = 0; k < 2; ++k) dst[m][k] = *(const PG8_LAS bf16x8*)(lds + PG8_SA(b, h) + aoff + m * 2048 + k * 1024); } } while (0)
#define PG8_LDB(dst, b, h) do { if constexpr (F8) { _Pragma("unroll") for (int n = 0; n < 2; ++n) { const v4i32_ lo_ = *(const PG8_LAS v4i32_*)(lds + PG8_SB(b, h) + boff + n * 2048), hi_ = *(const PG8_LAS v4i32_*)(lds + PG8_SB(b, h) + boff + n * 2048 + 1024); dst##8[n] = __builtin_shufflevector(lo_, hi_, 0, 1, 2, 3, 4, 5, 6, 7); } } \
        else { _Pragma("unroll") for (int n = 0; n < 2; ++n) _Pragma("unroll") for (int k = 0; k < 2; ++k) dst[n][k] = *(const PG8_LAS bf16x8*)(lds + PG8_SB(b, h) + boff + n * 2048 + k * 1024); } } while (0)
#define PG8_MMA(ai, bj, At, Bt) do { __builtin_amdgcn_s_setprio(1); \
        if constexpr (F8) { _Pragma("unroll") for (int m = 0; m < 4; ++m) _Pragma("unroll") for (int n = 0; n < 2; ++n) \
            acc[ai][bj][m][n] = __builtin_amdgcn_mfma_scale_f32_16x16x128_f8f6f4(Bt##8[n], At##8[m], acc[ai][bj][m][n], 0, 0, 0, 0x7f7f7f7f, 0, 0x7f7f7f7f); } \
        else { _Pragma("unroll") for (int m = 0; m < 4; ++m) _Pragma("unroll") for (int n = 0; n < 2; ++n) _Pragma("unroll") for (int k = 0; k < 2; ++k) \
            acc[ai][bj][m][n] = __builtin_amdgcn_mfma_f32_16x16x32_bf16(Bt[n][k], At[m][k], acc[ai][bj][m][n], 0, 0, 0); } \
        __builtin_amdgcn_s_setprio(0); } while (0)
#define PG8_WAIT_V(n) asm volatile("s_waitcnt vmcnt(" #n ")" ::: "memory")
#define PG8_WAIT_L(n) asm volatile("s_waitcnt lgkmcnt(" #n ")" ::: "memory")
#define PG8_BAR __builtin_amdgcn_s_barrier()
#define PG8_SCHED __builtin_amdgcn_sched_barrier(0)
    Unit cur, nxt; int ui = 0; RowPf pf;
    if (!S.next(0, cur)) return;
    float z0_; asm volatile("v_mov_b32 %0, 0" : "=v"(z0_));
    f32x4 acc[2][2][4][2];
#pragma unroll
    for (int a = 0; a < 2; ++a)
#pragma unroll
        for (int b = 0; b < 2; ++b)
#pragma unroll
            for (int m = 0; m < 4; ++m)
#pragma unroll
                for (int n = 0; n < 2; ++n) acc[a][b][m][n] = (f32x4){z0_, z0_, z0_, z0_};
    bf16x8 At[4][2], B0[2][2], B1[2][2]; v8i32_ At8[4], B08[2], B18[2];
    const char* cA = (const char*)g.A + (size_t)cur.pm * tstepA; const char* cB = (const char*)g.Bt + (size_t)cur.pn * tstepB;
    S.a_ready(cur);
    if constexpr (SP2) {
        PG8_STAGE(PG8_SB(0, 0), cB, voffB); PG8_STAGE(PG8_SB(0, 1), cB + hstepB, voffB); PG8_STAGE(PG8_SA(0, 0), cA, voffA); PG8_STAGE(PG8_SA(0, 1), cA + hstepA, voffA);
        if (wr == 1) PG8_BAR;
        PG8_WAIT_V(2); PG8_BAR;
        PG8_STAGE(PG8_SB(1, 0), cB + kstep, voffB); PG8_STAGE(PG8_SA(1, 0), cA + kstep, voffA); PG8_STAGE(PG8_SB(1, 1), cB + hstepB + kstep, voffB);
        PG8_WAIT_V(6); PG8_BAR;
    } else {
        PG8_STAGE(PG8_SB(0, 0), cB, voffB); PG8_STAGE(PG8_SA(0, 0), cA, voffA); PG8_STAGE(PG8_SB(0, 1), cB + hstepB, voffB); PG8_STAGE(PG8_SA(0, 1), cA + hstepA, voffA);
        if (wr == 1) PG8_BAR;
        PG8_WAIT_V(4); PG8_BAR;
        PG8_STAGE(PG8_SB(1, 0), cB + kstep, voffB); PG8_STAGE(PG8_SA(1, 0), cA + kstep, voffA); PG8_STAGE(PG8_SB(1, 1), cB + hstepB + kstep, voffB);
        PG8_WAIT_V(6); PG8_BAR;
    }
    for (;;) {
        const bool has_next = S.next(ui + 1, nxt);
        const char* nA = has_next ? (const char*)g.A + (size_t)nxt.pm * tstepA : cA; const char* nB = has_next ? (const char*)g.Bt + (size_t)nxt.pn * tstepB : cB;
#pragma unroll 1
        for (int t = 0; t < nt; t += 2) {
            const bool last = (t == nt - 2);
            const char* a1 = cA + (size_t)(t + 1) * kstep;
            const char* a2 = last ? nA : cA + (size_t)(t + 2) * kstep; const char* b2 = last ? nB : cB + (size_t)(t + 2) * kstep;
            const char* a3 = a2 + kstep; const char* b3 = b2 + kstep;
            if (last && has_next) S.a_ready(nxt);
            if (last) E.prefetch(pf, cur, wr, fr, tid);
            if constexpr (SP2) {
            PG8_LDB(B0, 0, 0); PG8_LDB(B1, 0, 1); PG8_SCHED; PG8_LDA(At, 0, 0); PG8_STAGE(PG8_SA(1, 1), a1 + hstepA, voffA);
            PG8_WAIT_V(8); PG8_WAIT_L(0); PG8_BAR; PG8_MMA(0, 0, At, B0); PG8_MMA(0, 1, At, B1); PG8_BAR; PG8_SCHED;
            PG8_LDA(At, 0, 1); PG8_STAGE(PG8_SB(0, 0), b2, voffB); PG8_STAGE(PG8_SB(0, 1), b2 + hstepB, voffB); PG8_STAGE(PG8_SA(0, 0), a2, voffA);
            PG8_WAIT_V(8); PG8_WAIT_L(0); PG8_BAR; PG8_MMA(1, 0, At, B0); PG8_MMA(1, 1, At, B1); PG8_BAR; PG8_SCHED;
            PG8_LDB(B0, 1, 0); PG8_LDB(B1, 1, 1); PG8_SCHED; PG8_LDA(At, 1, 0); PG8_STAGE(PG8_SA(0, 1), a2 + hstepA, voffA);
            PG8_WAIT_V(8); PG8_WAIT_L(0); PG8_BAR; PG8_MMA(0, 0, At, B0); PG8_MMA(0, 1, At, B1); PG8_BAR; PG8_SCHED;
            PG8_LDA(At, 1, 1); PG8_STAGE(PG8_SB(1, 0), b3, voffB); PG8_STAGE(PG8_SB(1, 1), b3 + hstepB, voffB); PG8_STAGE(PG8_SA(1, 0), a3, voffA);
            PG8_WAIT_V(8); PG8_WAIT_L(0); PG8_BAR; PG8_MMA(1, 0, At, B0); PG8_MMA(1, 1, At, B1); PG8_BAR; PG8_SCHED;
            } else {
            PG8_LDB(B0, 0, 0); PG8_SCHED; PG8_LDA(At, 0, 0); PG8_STAGE(PG8_SA(1, 1), a1 + hstepA, voffA);
            PG8_WAIT_L(8); PG8_BAR; PG8_WAIT_L(0); PG8_MMA(0, 0, At, B0); PG8_BAR; PG8_SCHED;
            PG8_LDB(B1, 0, 1); PG8_STAGE(PG8_SB(0, 0), b2, voffB);
            PG8_BAR; PG8_WAIT_L(0); PG8_MMA(0, 1, At, B1); PG8_BAR;
            PG8_LDA(At, 0, 1); PG8_STAGE(PG8_SA(0, 0), a2, voffA);
            PG8_BAR; PG8_WAIT_L(0); PG8_MMA(1, 0, At, B0); PG8_BAR; PG8_SCHED;
            PG8_STAGE(PG8_SB(0, 1), b2 + hstepB, voffB);
            PG8_WAIT_V(6); PG8_BAR; PG8_MMA(1, 1, At, B1); PG8_BAR;
            PG8_LDB(B0, 1, 0); PG8_SCHED; PG8_LDA(At, 1, 0); PG8_STAGE(PG8_SA(0, 1), a2 + hstepA, voffA);
            PG8_WAIT_L(8); PG8_BAR; PG8_WAIT_L(0); PG8_MMA(0, 0, At, B0); PG8_BAR; PG8_SCHED;
            PG8_LDB(B1, 1, 1); PG8_STAGE(PG8_SB(1, 0), b3, voffB);
            PG8_BAR; PG8_WAIT_L(0); PG8_MMA(0, 1, At, B1); PG8_BAR;
            PG8_LDA(At, 1, 1); PG8_STAGE(PG8_SA(1, 0), a3, voffA);
            PG8_BAR; PG8_WAIT_L(0); PG8_MMA(1, 0, At, B0); PG8_BAR; PG8_SCHED;
            PG8_STAGE(PG8_SB(1, 1), b3 + hstepB, voffB);
            PG8_WAIT_V(6); PG8_BAR; PG8_MMA(1, 1, At, B1); PG8_BAR;
            }
        }
        if constexpr (ALIGN_EPI) { if (wr == 0) PG8_BAR; }
        if constexpr (!Epi::AFTER_DRAIN) { E(acc, cur, wr, wc, fr, fq, pf); S.done(cur); }
        if (!has_next) break;
        float z1_; asm volatile("v_mov_b32 %0, 0" : "=v"(z1_));
#pragma unroll
        for (int a = 0; a < 2; ++a)
#pragma unroll
            for (int b = 0; b < 2; ++b)
#pragma unroll
                for (int m = 0; m < 4; ++m)
#pragma unroll
                    for (int n = 0; n < 2; ++n) acc[a][b][m][n] = (f32x4){z1_, z1_, z1_, z1_};
        cur = nxt; cA = nA; cB = nB; ++ui;
        if constexpr (ALIGN_EPI) { if (wr == 1) PG8_BAR; }
    }
    PG8_WAIT_V(0);
    if constexpr (!ALIGN_EPI) { if (wr == 0) PG8_BAR; }
    PG8_BAR;
    if constexpr (Epi::AFTER_DRAIN) { E.fused(acc, cur, wr, wc, fr, fq, lds, wid, lane); S.done(cur); }
#undef PG8_SA
#undef PG8_SB
#undef PG8_STAGE
#undef PG8_LDA
#undef PG8_LDB
#undef PG8_MMA
#undef PG8_WAIT_V
#undef PG8_WAIT_L
#undef PG8_BAR
#undef PG8_SCHED
}
}

#define XB_TMO      128
#define XB_XCNT(j)  (256  + 64 * (j))
#define XB_XSUB(j)  (1280 + 64 * (j))
#define XB_XGEN(j)  (2304 + 64 * (j))
#define XB_TOP      3328
#define XB_TOPGEN   3392
#define XCD_BAR_WORDS 3456
#define XB_SPIN_CAP (1u << 23)

__device__ __forceinline__ unsigned xb_ld(unsigned* p)              { return __hip_atomic_load(p, __ATOMIC_RELAXED, __HIP_MEMORY_SCOPE_AGENT); }
__device__ __forceinline__ unsigned xb_add(unsigned* p, unsigned v) { return __hip_atomic_fetch_add(p, v, __ATOMIC_RELAXED, __HIP_MEMORY_SCOPE_AGENT); }
__device__ __forceinline__ unsigned xb_xcc_id() { return (unsigned)__builtin_amdgcn_s_getreg((3 << 11) | 20) & 0xFu; }
#define XB_SPIN(cond, bar) do { unsigned _sp = 0; while (cond) { __builtin_amdgcn_s_sleep(1); \
    if ((++_sp & 255u) == 0u) { if (xb_ld(&(bar)[XB_TMO])) break; if (_sp > XB_SPIN_CAP) { atomicAdd(&(bar)[XB_TMO], 1u); break; } } } } while (0)

struct XcdBarrier {
    unsigned* bar; unsigned x;
    volatile LAS unsigned* st;
};

__device__ __forceinline__ XcdBarrier xcd_barrier_post(unsigned* bar, volatile LAS unsigned* st) {
    XcdBarrier b; b.bar = bar; b.x = xb_xcc_id(); b.st = st;
    if (ltid() == 0) (void)xb_add(&bar[XB_XCNT(b.x)], 1u);
    return b;
}
__device__ __forceinline__ void xcd_barrier_complete(unsigned* bar, unsigned x, unsigned& nloc, unsigned& nx) {
    const unsigned G = gridDim.x * gridDim.y * gridDim.z;
    unsigned sum, cnt, mine, sp = 0u;
    for (;;) {
        sum = 0u; cnt = 0u; mine = 0u;
#pragma unroll
        for (unsigned j = 0; j < 16; ++j) { const unsigned c = xb_ld(&bar[XB_XCNT(j)]); sum += c; cnt += (c > 0u) ? 1u : 0u; mine = (j == x) ? c : mine; }
        if (sum == G) break;
        __builtin_amdgcn_s_sleep(1);
        if ((++sp & 255u) == 0u) { if (xb_ld(&bar[XB_TMO])) break; if (sp > XB_SPIN_CAP) { atomicAdd(&bar[XB_TMO], 1u); break; } }
    }
    nloc = mine > 0u ? mine : 1u; nx = cnt > 0u ? cnt : 1u;
}

__device__ __forceinline__ void xcd_barrier(const XcdBarrier& b) {
    asm volatile("s_waitcnt vmcnt(0)" ::: "memory");
    __syncthreads();
    if (ltid() == 0) {
        unsigned* bar = b.bar;
        __builtin_amdgcn_s_waitcnt(0);
        unsigned nloc = b.st[0], nx = b.st[1];
        if (nloc == 0u) { xcd_barrier_complete(bar, b.x, nloc, nx); b.st[0] = nloc; b.st[1] = nx; }
        const unsigned old = xb_add(&bar[XB_XSUB(b.x)], 1u);
        const unsigned gen = old / nloc;
        if (old + 1u == (gen + 1u) * nloc) {
            __builtin_amdgcn_fence(__ATOMIC_RELEASE, "agent");
            asm volatile("s_waitcnt vmcnt(0)" ::: "memory");
            const unsigned og = xb_add(&bar[XB_TOP], 1u);
            const unsigned tg = og / nx;
            if (og + 1u == (tg + 1u) * nx) xb_add(&bar[XB_TOPGEN], 1u);
            else XB_SPIN(xb_ld(&bar[XB_TOPGEN]) == tg, bar);
            __builtin_amdgcn_fence(__ATOMIC_ACQUIRE, "agent");
            xb_add(&bar[XB_XGEN(b.x)], 1u);
            asm volatile("s_waitcnt vmcnt(0)" ::: "memory");
        } else {
            XB_SPIN(xb_ld(&bar[XB_XGEN(b.x)]) == gen, bar);
            __builtin_amdgcn_fence(__ATOMIC_ACQUIRE, "agent");
            asm volatile("s_waitcnt vmcnt(0)" ::: "memory");
        }
    }
    __syncthreads();
}

namespace fox_body {
using bf16=__hip_bfloat16;
using bf16x8=__attribute__((ext_vector_type(8)))short;
using s16x4=__attribute__((ext_vector_type(4)))short;
using f32x16=__attribute__((ext_vector_type(16)))float;
using u32x4=__attribute__((ext_vector_type(4)))unsigned;
constexpr int SEQ=2048,D=64,DM=3328,OM=1280;
constexpr int NW=8,QBLK=32,QB=QBLK*NW,KVBLK=64,NQB=SEQ/QB;
constexpr int ATTN_PITCH=DM, ATTN_UNIT_ROWS=QB;
__device__ __forceinline__ int crow(int r,int hi){return (r&3)+8*(r>>2)+4*hi;}
#define SBAR() __builtin_amdgcn_sched_barrier(0)
__device__ __forceinline__ void cmask(f32x16&p0,f32x16&p1,int jb,int qrel,int hi){
  const float NEG=-INFINITY; int kb=64*jb+4*hi;
  #pragma unroll
  for(int r=0;r<16;++r){int kv=kb+(r&3)+8*(r>>2); if(kv>qrel)p0[r]=NEG; if(kv+32>qrel)p1[r]=NEG;}
}

constexpr int NSLOT=3, SLOTB=8192;
constexpr int LDS_K=0, LDS_V=NSLOT*SLOTB, LDS_WS=2*NSLOT*SLOTB, LDS_OST=LDS_WS+NW*64*4, LDS_BYTES=LDS_OST+NW*4096, LDS_CPK=LDS_BYTES, LDS_TOTAL=LDS_CPK+SEQ*4;
constexpr float C2=0.125f*1.4426950408889634f;
__device__ __forceinline__ void glds16(const void*gsrc,unsigned lds_dst){unsigned keep;
  asm volatile("s_mov_b32 %0, m0\n\ts_mov_b32 m0, %2\n\ts_nop 0\n\tglobal_load_lds_dwordx4 %1, off\n\ts_mov_b32 m0, %0":"=&s"(keep):"v"(gsrc),"s"(lds_dst):"memory");}
__device__ __forceinline__ float max3f(float a,float b,float c){float r;asm("v_max3_f32 %0, %1, %2, %3":"=v"(r):"v"(a),"v"(b),"v"(c));return r;}
__device__ __forceinline__ float max2f(float a,float b){float r;asm("v_max_f32_e32 %0, %1, %2":"=v"(r):"v"(a),"v"(b));return r;}
__device__ __forceinline__ float fadd_s(float a,float b){float r;asm("v_add_f32_e32 %0, %1, %2":"=v"(r):"v"(a),"v"(b));return r;}
__device__ __forceinline__ float fsub_s(float a,float b){float r;asm("v_sub_f32_e32 %0, %1, %2":"=v"(r):"v"(a),"v"(b));return r;}
typedef float f32x2_t __attribute__((ext_vector_type(2))); typedef __bf16 bf16x2_t __attribute__((ext_vector_type(2)));
__device__ __forceinline__ unsigned cvtpk_s(float lo,float hi){f32x2_t v={lo,hi};bf16x2_t b=__builtin_convertvector(v,bf16x2_t);return __builtin_bit_cast(unsigned,b);}
#define WAIT_BAR(N) asm volatile("s_waitcnt vmcnt(" #N ") lgkmcnt(0)\n\ts_barrier":::"memory")

__device__ __forceinline__ void qkt(f32x16&p0,f32x16&p1,const char*Kslot,const bf16x8*qr,int r32,int hi,bf16x8 kx0,bf16x8 kx1,bf16x8 qx){
  const char*kb=Kslot+hi*1024+r32*16;
  #pragma unroll
  for(int d0=0;d0<4;++d0){
    const bf16x8 b0=*reinterpret_cast<const bf16x8*>(kb+d0*2048);
    const bf16x8 b1=*reinterpret_cast<const bf16x8*>(kb+d0*2048+512);
    if(d0==0){p0=__builtin_amdgcn_mfma_f32_32x32x16_bf16(b0,qr[0],f32x16{},0,0,0);p1=__builtin_amdgcn_mfma_f32_32x32x16_bf16(b1,qr[0],f32x16{},0,0,0);}
    else{p0=__builtin_amdgcn_mfma_f32_32x32x16_bf16(b0,qr[d0],p0,0,0,0);p1=__builtin_amdgcn_mfma_f32_32x32x16_bf16(b1,qr[d0],p1,0,0,0);}}
  p0=__builtin_amdgcn_mfma_f32_32x32x16_bf16(kx0,qx,p0,0,0,0);p1=__builtin_amdgcn_mfma_f32_32x32x16_bf16(kx1,qx,p1,0,0,0);
}
typedef __attribute__((address_space(3))) const char* lds_cptr;
typedef short v4i16_t __attribute__((ext_vector_type(4)));
__device__ __forceinline__ void kload8(bf16x8*kf,lds_cptr kp){
  kf[0]=*(const __attribute__((address_space(3))) bf16x8*)(kp);      kf[1]=*(const __attribute__((address_space(3))) bf16x8*)(kp+512);
  kf[2]=*(const __attribute__((address_space(3))) bf16x8*)(kp+2048); kf[3]=*(const __attribute__((address_space(3))) bf16x8*)(kp+2560);
  kf[4]=*(const __attribute__((address_space(3))) bf16x8*)(kp+4096); kf[5]=*(const __attribute__((address_space(3))) bf16x8*)(kp+4608);
  kf[6]=*(const __attribute__((address_space(3))) bf16x8*)(kp+6144); kf[7]=*(const __attribute__((address_space(3))) bf16x8*)(kp+6656);
}
__device__ __forceinline__ void kload2(bf16x8*kf,lds_cptr kp,int j){ kf[2*j]=*(const __attribute__((address_space(3))) bf16x8*)(kp+j*2048); kf[2*j+1]=*(const __attribute__((address_space(3))) bf16x8*)(kp+j*2048+512); }
__device__ __forceinline__ s16x4 vtr(lds_cptr p){ return __builtin_bit_cast(s16x4,__builtin_amdgcn_ds_read_tr16_b64_v4i16((__attribute__((address_space(3))) v4i16_t*)p)); }
__device__ __forceinline__ float rowmax(const f32x16&p0,const f32x16&p1){
  float a=max3f(p0[0],p0[1],p1[0]),b=max3f(p0[2],p0[3],p1[1]);a=max3f(a,p1[2],p1[3]);
  #pragma unroll
  for(int r=4;r<16;r+=4){a=max3f(a,p0[r],p0[r+1]);b=max3f(b,p0[r+2],p0[r+3]);a=max3f(a,p1[r],p1[r+1]);b=max3f(b,p1[r+2],p1[r+3]);}
  const float m=max2f(a,b);
  auto rr=__builtin_amdgcn_permlane32_swap(__float_as_uint(m),__float_as_uint(m),false,false);
  return max2f(__uint_as_float(rr[0]),__uint_as_float(rr[1]));
}
__device__ __forceinline__ void pv(f32x16*o,int vb,bf16x8 pa0,bf16x8 pa1,bf16x8 pa2,bf16x8 pa3){
  #pragma unroll
  for(int d0=0;d0<2;++d0){s16x4 lo[4],hi[4];
    #pragma unroll
    for(int ks=0;ks<4;++ks){
      asm volatile("ds_read_b64_tr_b16 %0,%1 offset:%c2":"=&v"(lo[ks]):"v"(vb),"i"(d0*4096+ks*1024):"memory");
      asm volatile("ds_read_b64_tr_b16 %0,%1 offset:%c2":"=&v"(hi[ks]):"v"(vb),"i"(d0*4096+ks*1024+512):"memory");}
    asm volatile("s_waitcnt lgkmcnt(0)":::"memory");SBAR();
    #define PK(k) (bf16x8){lo[k][0],lo[k][1],lo[k][2],lo[k][3],hi[k][0],hi[k][1],hi[k][2],hi[k][3]}
    o[d0]=__builtin_amdgcn_mfma_f32_32x32x16_bf16(pa0,PK(0),o[d0],0,0,0);
    o[d0]=__builtin_amdgcn_mfma_f32_32x32x16_bf16(pa1,PK(1),o[d0],0,0,0);
    o[d0]=__builtin_amdgcn_mfma_f32_32x32x16_bf16(pa2,PK(2),o[d0],0,0,0);
    o[d0]=__builtin_amdgcn_mfma_f32_32x32x16_bf16(pa3,PK(3),o[d0],0,0,0);
    #undef PK
  }
}

#ifndef ATTN_STORE16
#define ATTN_STORE16(p,v) (*(u32x4*)(p)=(v))
#endif
template<int THRL> __device__ __forceinline__ void attn_unit(int b,int h,int qb,const bf16*Q,const bf16*__restrict__ K,const bf16*__restrict__ V,bf16*O,char*shm){
  const int tid_=ltid(); const int tid=tid_,lane=tid&63,r32=lane&31,hi=lane>>5;     const int wid=__builtin_amdgcn_readfirstlane(tid>>6);
  const long rowbase=(long)b*SEQ; const int q0=qb*QB;
  const bf16*Qw=Q+(rowbase+q0+wid*QBLK)*DM+h*D;
  const __attribute__((address_space(3))) unsigned* cpk3=(const __attribute__((address_space(3))) unsigned*)((__attribute__((address_space(3))) const char*)shm+LDS_CPK);
  const bf16*Kh=K+rowbase*DM+h*D,*Vh=V+rowbase*DM+h*D;
  const unsigned lds0=(unsigned)(uintptr_t)shm;
  float*wsf=(float*)(shm+LDS_WS)+wid*64;
  const bf16*ksrc=Kh+(long)lane*DM+wid*8;
  const bf16*vsrc=Vh+(long)(16*(wid&3)+(lane>>2))*DM+(wid>>2)*32+(lane&3)*8;
  const unsigned kdst=lds0+LDS_K+wid*1024, vdst=lds0+LDS_V+wid*1024;
  #define DMA_K(t,slot) glds16(ksrc+(long)(t)*KVBLK*DM,(unsigned)__builtin_amdgcn_readfirstlane(kdst+(slot)))
  #define DMA_V(t,slot) glds16(vsrc+(long)(t)*KVBLK*DM,(unsigned)__builtin_amdgcn_readfirstlane(vdst+(slot)))
  const int vb0=(int)(lds0+LDS_V)+((lane>>4)&1)*32+(lane&3)*8+(4*hi+((lane&15)>>2))*64;
  const char*Kbase=shm+LDS_K; bf16x8 kf[8];
  const lds_cptr shm3=(lds_cptr)shm; const lds_cptr kp0=shm3+LDS_K+hi*1024+r32*16; const lds_cptr vp0=shm3+LDS_V+((lane>>4)&1)*32+(lane&3)*8+(4*hi+((lane&15)>>2))*64;
  const int NT=(q0+QB)/KVBLK;
  DMA_K(0,0);DMA_V(0,0);DMA_K(1,SLOTB);
  bf16x8 qr[4];
  #pragma unroll
  for(int d0=0;d0<4;++d0)qr[d0]=*reinterpret_cast<const bf16x8*>(&Qw[(long)r32*DM+d0*16+hi*8]);
  u32x4 qxw; { const unsigned cq_=cpk3[q0+wid*QBLK+r32]^0x80008000u; qxw=hi?(u32x4){0u,0u,0u,0u}:(u32x4){cq_,0x3f803f80u,0u,0u}; }
  #define QX __builtin_bit_cast(bf16x8,qxw)
  #define QXM() do{ const unsigned hb_=cvtpk_s(mhat,0.f)&0xffffu; const float hf_=__uint_as_float(hb_<<16); const unsigned pk_=cvtpk_s(hf_,mhat-hf_); qxw[2]=hi?0u:pk_; }while(0)
  #define KXF(kv) __builtin_bit_cast(bf16x8,(u32x4){0x3f803f80u,cpk3[(kv)],0xbf80bf80u,0u})
  float mhat=0.f,l_reg=0.f;f32x16 o[2];o[0]=f32x16{};o[1]=f32x16{};
  const int qrel=wid*QBLK+r32;
  #define CMASK(P0,P1,t) do{int jb_=(t)-(NT-4); if(jb_>=0)cmask(P0,P1,jb_,qrel,hi);}while(0)
  bool resc=false;
  #define START(P0,P1) do{ const float rm=__builtin_fmaxf(rowmax(P0,P1),-24.f); resc=false;   \
    { const float dl=rm; mhat=fadd_s(mhat,dl); \
      _Pragma("unroll") for(int r=0;r<16;++r){P0[r]=fsub_s(P0[r],dl);P1[r]=fsub_s(P1[r],dl);} \
      QXM(); } \
    _Pragma("unroll") for(int r=0;r<16;++r)P0[r]=__builtin_amdgcn_exp2f(P0[r]); }while(0)
  #define RESC() do{ if(resc){ asm volatile("s_waitcnt lgkmcnt(0)":::"memory"); \
      _Pragma("unroll") for(int d_=0;d_<2;++d_) _Pragma("unroll") for(int r=0;r<16;++r)o[d_][r]*=wsf[crow(r,hi)]; } }while(0)
  f32x16 pA0,pA1,pB0,pB1;
  int sl_prev=0,sl_cur=0,sl_next=SLOTB;
  #define ROT() do{sl_prev=sl_cur;sl_cur=sl_next;sl_next=(sl_next==(NSLOT-1)*SLOTB)?0:sl_next+SLOTB;}while(0)
  DMA_K(2,2*SLOTB);
  WAIT_BAR(3);
  qkt(pA0,pA1,Kbase,qr,r32,hi,KXF(r32),KXF(32+r32),QX);asm volatile("s_nop 15\n\ts_nop 7":"+v"(pA0),"+v"(pA1));CMASK(pA0,pA1,0);
  START(pA0,pA1);
  _Pragma("unroll") for(int r=0;r<16;++r)pA1[r]=__builtin_amdgcn_exp2f(pA1[r]);
  WAIT_BAR(0);
  DMA_K(3,0);DMA_V(1,SLOTB);
  ROT();
  kload8(kf,kp0+sl_cur);
  WAIT_BAR(2);
  s16x4 vlo[8],vhi[8]; u32x4 pw0,pw1,pw2,pw3;
  #define PKW(P,B) cvtpk_s(P[B],P[B+1])
  #define PAF(k) __builtin_bit_cast(bf16x8,pw##k)
  #define VFR(i) (bf16x8){vlo[i][0],vlo[i][1],vlo[i][2],vlo[i][3],vhi[i][0],vhi[i][1],vhi[i][2],vhi[i][3]}
  #define PIN(x) asm volatile("":"+v"(x))
  #define MX3(a,b,c) __builtin_fmaxf(__builtin_fmaxf((a),(b)),(c))
  #define GAPA(MF,A0,A1,A2,A3,W0,W1,PW) do{ MF; sacc+=A0; sacc+=A1; sacc+=A2; sacc+=A3; PIN(sacc); W0; W1; PIN(PW); SBAR(); }while(0)
  #define EX(v) __builtin_amdgcn_exp2f(v)
  #define GAPB(MF,X,B) do{ MF; X[B]=EX(X[B]); X[B+1]=EX(X[B+1]); X[B+2]=EX(X[B+2]); X[B+3]=EX(X[B+3]); PIN(X); SBAR(); }while(0)
  #define VRD(i) do{ vlo[i]=vtr(vp_+(((i)>>2)*4096+((i)&3)*1024)); vhi[i]=vtr(vp_+(((i)>>2)*4096+((i)&3)*1024+512)); }while(0)
  #define KRD(G,j) do{ if(G){ kload2(kf,kp0+sl_next,j); SBAR(); } }while(0)
  #define STEP(C0,C1,P0,P1,t,GK,GV,GL) do{ SBAR(); \
    const lds_cptr vp_=vp0+sl_prev; const bf16x8 kx0_=KXF((t)*64+r32), kx1_=KXF((t)*64+32+r32); \
    VRD(0); SBAR(); float sacc=(P0[0]+P0[1]); \
    GAPA(C0=__builtin_amdgcn_mfma_f32_32x32x16_bf16(kf[0],qr[0],f32x16{},0,0,0), P0[2],P0[3],P0[4],P0[5],     pw0[0]=PKW(P0,0), pw0[1]=PKW(P0,2), pw0); \
    VRD(4); SBAR(); GAPA(C1=__builtin_amdgcn_mfma_f32_32x32x16_bf16(kf[1],qr[0],f32x16{},0,0,0), P0[6],P0[7],P0[8],P0[9],     pw0[2]=PKW(P0,4), pw0[3]=PKW(P0,6), pw0); \
    VRD(1); SBAR(); GAPA(C0=__builtin_amdgcn_mfma_f32_32x32x16_bf16(kf[2],qr[1],C0,0,0,0),   P0[10],P0[11],P0[12],P0[13], pw1[0]=PKW(P0,8), pw1[1]=PKW(P0,10), pw1); \
    VRD(5); SBAR(); GAPA(C1=__builtin_amdgcn_mfma_f32_32x32x16_bf16(kf[3],qr[1],C1,0,0,0),   P0[14],P0[15],P1[0],P1[1],   pw1[2]=PKW(P0,12),pw1[3]=PKW(P0,14), pw1); \
    VRD(2); SBAR(); GAPA(C0=__builtin_amdgcn_mfma_f32_32x32x16_bf16(kf[4],qr[2],C0,0,0,0),   P1[2],P1[3],P1[4],P1[5],     pw2[0]=PKW(P1,0), pw2[1]=PKW(P1,2), pw2); \
    VRD(6); SBAR(); GAPA(C1=__builtin_amdgcn_mfma_f32_32x32x16_bf16(kf[5],qr[2],C1,0,0,0),   P1[6],P1[7],P1[8],P1[9],     pw2[2]=PKW(P1,4), pw2[3]=PKW(P1,6), pw2); \
    VRD(3); SBAR(); GAPA(C0=__builtin_amdgcn_mfma_f32_32x32x16_bf16(kf[6],qr[3],C0,0,0,0),   P1[10],P1[11],P1[12],P1[13], pw3[0]=PKW(P1,8), pw3[1]=PKW(P1,10), pw3); \
    VRD(7); SBAR(); GAPA(C1=__builtin_amdgcn_mfma_f32_32x32x16_bf16(kf[7],qr[3],C1,0,0,0),   P1[14],P1[15],0.f,0.f,       pw3[2]=PKW(P1,12),pw3[3]=PKW(P1,14), pw3); \
    C0=__builtin_amdgcn_mfma_f32_32x32x16_bf16(kx0_,QX,C0,0,0,0); C1=__builtin_amdgcn_mfma_f32_32x32x16_bf16(kx1_,QX,C1,0,0,0); \
    l_reg+=sacc; \
    if(GK){DMA_K((t)+3,sl_cur);} if(GV){DMA_V((t)+1,sl_next);} \
    CMASK(C0,C1,t); \
    { float a=MX3(C0[0],C0[1],C1[0]),b=MX3(C0[2],C0[3],C1[1]); a=MX3(a,C1[2],C1[3]); \
      _Pragma("unroll") for(int r=4;r<16;r+=4){a=MX3(a,C0[r],C0[r+1]);b=MX3(b,C0[r+2],C0[r+3]);a=MX3(a,C1[r],C1[r+1]);b=MX3(b,C1[r+2],C1[r+3]);} \
      float rm=__builtin_fmaxf(a,b); { auto rr=__builtin_amdgcn_permlane32_swap(__float_as_uint(rm),__float_as_uint(rm),false,false); rm=__builtin_fmaxf(__uint_as_float(rr[0]),__uint_as_float(rr[1])); } \
      resc=false; \
      if(__builtin_expect(__any(rm>(float)THRL),0)){ const float dl=__builtin_fmaxf(rm,0.f); mhat+=dl; \
        _Pragma("unroll") for(int r=0;r<16;++r){C0[r]-=dl;C1[r]-=dl;} \
        QXM(); \
        const float f=__builtin_amdgcn_exp2f(-dl); l_reg*=f; if(hi==0)wsf[r32]=f; resc=true; } } \
    SBAR(); \
    GAPB(o[0]=__builtin_amdgcn_mfma_f32_32x32x16_bf16(PAF(0),VFR(0),o[0],0,0,0), C0,0); \
    GAPB(o[1]=__builtin_amdgcn_mfma_f32_32x32x16_bf16(PAF(0),VFR(4),o[1],0,0,0), C0,4); \
    KRD(GL,0); GAPB(o[0]=__builtin_amdgcn_mfma_f32_32x32x16_bf16(PAF(1),VFR(1),o[0],0,0,0), C0,8); \
    KRD(GL,1); GAPB(o[1]=__builtin_amdgcn_mfma_f32_32x32x16_bf16(PAF(1),VFR(5),o[1],0,0,0), C0,12); \
    KRD(GL,2); GAPB(o[0]=__builtin_amdgcn_mfma_f32_32x32x16_bf16(PAF(2),VFR(2),o[0],0,0,0), C1,0); \
    KRD(GL,3); GAPB(o[1]=__builtin_amdgcn_mfma_f32_32x32x16_bf16(PAF(2),VFR(6),o[1],0,0,0), C1,4); \
    GAPB(o[0]=__builtin_amdgcn_mfma_f32_32x32x16_bf16(PAF(3),VFR(3),o[0],0,0,0), C1,8); \
    GAPB(o[1]=__builtin_amdgcn_mfma_f32_32x32x16_bf16(PAF(3),VFR(7),o[1],0,0,0), C1,12); \
    }while(0)
  int t=1;
  #undef CMASK
  #define CMASK(P0,P1,t) do{}while(0)
  for(;t+5<NT;t+=2){
    STEP(pB0,pB1,pA0,pA1,t,true,true,true);     WAIT_BAR(2); RESC(); ROT();
    STEP(pA0,pA1,pB0,pB1,t+1,true,true,true);   WAIT_BAR(2); RESC(); ROT();
  }
  #undef CMASK
  #define CMASK(P0,P1,t) do{int jb_=(t)-(NT-4); if(jb_>=0)cmask(P0,P1,jb_,qrel,hi);}while(0)
  #define ENDW(tt) do{ if((tt)+3<NT){WAIT_BAR(2);} else if((tt)+2<NT){WAIT_BAR(1);} else {WAIT_BAR(0);} }while(0)
  for(;t+1<NT;t+=2){
    STEP(pB0,pB1,pA0,pA1,t,(t+3<NT),(t+1<NT),(t+1<NT));       ENDW(t);   RESC(); ROT();
    STEP(pA0,pA1,pB0,pB1,t+1,(t+4<NT),(t+2<NT),(t+2<NT));     ENDW(t+1); RESC(); ROT();
  }
  STEP(pB0,pB1,pA0,pA1,NT-1,false,false,false); RESC();
  { float sacc=pB0[0]+pB0[1]; _Pragma("unroll") for(int r=2;r<16;++r)sacc+=pB0[r]; _Pragma("unroll") for(int r=0;r<16;++r)sacc+=pB1[r]; l_reg+=sacc;
    pw0=(u32x4){PKW(pB0,0),PKW(pB0,2),PKW(pB0,4),PKW(pB0,6)};pw1=(u32x4){PKW(pB0,8),PKW(pB0,10),PKW(pB0,12),PKW(pB0,14)};pw2=(u32x4){PKW(pB1,0),PKW(pB1,2),PKW(pB1,4),PKW(pB1,6)};pw3=(u32x4){PKW(pB1,8),PKW(pB1,10),PKW(pB1,12),PKW(pB1,14)};
    SBAR(); pv(o,vb0+sl_cur,PAF(0),PAF(1),PAF(2),PAF(3)); }
  #undef PKW
  #undef PAF
  #undef VFR
  #undef PIN
  #undef MX3
  #undef GAPA
  #undef GAPB
  #undef EX
  #undef VRD
  #undef KRD
  #undef KXF
  #undef QX
  #undef QXM
  #undef STEP
  #undef ENDW
  {auto rr=__builtin_amdgcn_permlane32_swap(__float_as_uint(l_reg),__float_as_uint(l_reg),false,false);l_reg=__uint_as_float(rr[0])+__uint_as_float(rr[1]);}
  if(hi==0)wsf[32+r32]=l_reg;asm volatile("s_waitcnt lgkmcnt(0)":::"memory");
  float rli[16];
  #pragma unroll
  for(int r=0;r<16;++r)rli[r]=__builtin_amdgcn_rcpf(wsf[32+crow(r,hi)]);
  bf16*Ow=O+(rowbase+q0+wid*QBLK)*OM+h*D;
  { bf16*stg=(bf16*)(shm+LDS_OST)+wid*2048;
    #pragma unroll
    for(int r=0;r<16;++r){const int orow=crow(r,hi);
      #pragma unroll
      for(int d0=0;d0<2;++d0)stg[orow*64+d0*32+r32]=__float2bfloat16(o[d0][r]*rli[r]);}
    asm volatile("s_waitcnt lgkmcnt(0)":::"memory");
    #pragma unroll
    for(int i=0;i<4;++i){const int row=i*8+(lane>>3),ch=lane&7; const u32x4 v=*(const u32x4*)(stg+row*64+ch*8); ATTN_STORE16(Ow+(long)row*OM+ch*8,v);} }
  asm volatile("s_waitcnt lgkmcnt(0)\n\ts_barrier":::"memory");
  #undef DMA_K
  #undef DMA_V
  #undef CMASK
  #undef START
  #undef RESC
  #undef ROT
}
#undef SBAR
#undef WAIT_BAR
}

__device__ __forceinline__ void fox_phase(char* shm, const bf16* PROJ, const float* SMALL, const float* fbias, bf16* Y) {
    LAS unsigned* cpk = (LAS unsigned*)((LAS unsigned char*)shm + fox_body::LDS_CPK); LAS float* wtot = (LAS float*)((LAS unsigned char*)shm + fox_body::LDS_TOTAL);
    for (int p = blockIdx.x; p < BATCH * 4 * 4; p += gridDim.x) {
        const int bh = p >> 2, s = p & 3, b = bh >> 2, h = bh & 3; const size_t rb = (size_t)b * SEQ;
        __syncthreads();
        { const int tid = ltid(), lane = tid & 63, wid = tid >> 6;
          float ls[4]; float run = 0.f; const float fbh = fbias[h];
#pragma unroll
          for (int i = 0; i < 4; ++i) ls[i] = SMALL[(rb + 4 * tid + i) * 16 + h];
          asm volatile("" ::: "memory");
#pragma unroll
          for (int i = 0; i < 4; ++i) { run += logsigmoidf_(ls[i] + fbh); ls[i] = run; }
          float inc = run;
#pragma unroll
          for (int o = 1; o < 64; o <<= 1) { const float t = lane_get(inc, lane - o); if (lane >= o) inc += t; }
          if (lane == 63) wtot[wid] = inc;
          __syncthreads();
          float base = inc - run;
          for (int w = 0; w < wid; ++w) base += wtot[w];
#pragma unroll
          for (int i = 0; i < 4; ++i) { const float neg = -(base + ls[i]) * LOG2E; const unsigned hi = f2bf(neg); const unsigned lo = f2bf(neg - __uint_as_float(hi << 16)); cpk[4 * tid + i] = hi | (lo << 16); } }
        __syncthreads();
        const fox_body::bf16* P = (const fox_body::bf16*)PROJ;
        fox_body::attn_unit<8>(b, 0, 7 - s, P + h * 64, P + 256 + h * 64, P + 512 + h * 64, (fox_body::bf16*)Y + h * 64, shm);
        fox_body::attn_unit<8>(b, 0, s, P + h * 64, P + 256 + h * 64, P + 512 + h * 64, (fox_body::bf16*)Y + h * 64, shm);
    }
    __syncthreads();
}


namespace mls {
typedef short v4i16 __attribute__((ext_vector_type(4)));
constexpr int QP = 72, VP = 88;
constexpr int O_Q = 0, O_K = 64 * QP * 2, O_V = 2 * 64 * QP * 2, BUF = O_V + 64 * VP * 2;
constexpr int O_PS = 2 * BUF, O_CT = O_PS + 64 * QP * 2, CTB = 80 * QP * 2, O_B2 = O_CT + 2 * CTB, O_U2 = O_B2 + 8192, O_UU = O_U2 + 8192, O_CH = O_UU + 8192, LDS_END = O_CH + 5 * 128;
static_assert(LDS_END <= 131072, "mLSTM LDS map");
__device__ __forceinline__ bf16x8 trfrag(const LAS bf16* base, int pitch, int row0, int col0, int fr, int fq) {
    const LAS bf16* p = base + (row0 + 8 * fq + (fr >> 2)) * pitch + col0 + 4 * (fr & 3);
    const v4i16 a = __builtin_amdgcn_ds_read_tr16_b64_v4i16((LAS v4i16*)p), b = __builtin_amdgcn_ds_read_tr16_b64_v4i16((LAS v4i16*)(p + 4 * pitch));
    return (bf16x8){a[0], a[1], a[2], a[3], b[0], b[1], b[2], b[3]};
}
__device__ __forceinline__ void unit(LAS unsigned char* L, int bh, int part, const bf16* PROJ, const float* SMALL, const float* ib, const float* fb, const float* hg, bf16* Y) {
    const int tid = ltid(), lane = tid & 63, wid = __builtin_amdgcn_readfirstlane(tid >> 6), fr = lane & 15, fq = lane >> 4;
    const int c_lo = part == 0 ? 0 : part == 1 ? 13 : part == 2 ? 22 : 28, c_hi = part == 0 ? 13 : part == 1 ? 22 : part == 2 ? 28 : 32;
    const int b = bh >> 2, h = bh & 3; const size_t rb = (size_t)b * SEQ;
    LAS float* B2 = (LAS float*)(L + O_B2); LAS float* U2 = (LAS float*)(L + O_U2); LAS float* UU = (LAS float*)(L + O_UU);
    LAS float* blast2 = (LAS float*)(L + O_CH); LAS float* umax2 = blast2 + 32; LAS float* mprev2 = blast2 + 64; LAS float* decay = blast2 + 96; LAS float* wl = blast2 + 128;
    const int lrow = tid >> 3, lc16 = tid & 7;
    const bf16* gsrc = PROJ + (rb + lrow) * NPROJ + 64 * h + 8 * lc16;
    const v4u q0_ = *(const v4u*)(gsrc + 1536), k0_ = *(const v4u*)(gsrc + 1792), v0_ = *(const v4u*)(gsrc + 2048);
    f32x4 gain4[4];
#pragma unroll
    for (int et = 0; et < 4; ++et) gain4[et] = *(const f32x4*)(hg + 64 * h + 16 * et + 4 * fq);
    __syncthreads();
    for (int i = tid; i < 2 * 64 * 16; i += 512) { const int bu = i >> 10, r = (i >> 4) & 63, c = i & 15; ((LAS bf16*)(L + bu * BUF + O_V))[r * VP + 64 + c] = c == 0 ? (bf16)0x3f80 : (bf16)0; }
    for (int i = tid; i < CTB / 4; i += 512) ((LAS unsigned*)(L + O_CT))[i] = 0u;
    float fpre[4], ipre[4];
#pragma unroll
    for (int j = 0; j < 4; ++j) { const size_t row = rb + 64 * (wid + 8 * j) + lane; fpre[j] = SMALL[row * 16 + 8 + h]; ipre[j] = SMALL[row * 16 + 4 + h]; }
#pragma unroll
    for (int j = 0; j < 4; ++j) {
        const int c = wid + 8 * j;
        const float lf = logsigmoidf_(fpre[j] + fb[h]), li = ipre[j] + ib[h];
        float bs = lf;
#pragma unroll
        for (int o = 1; o < 64; o <<= 1) { const float t = lane_get(bs, lane - o); if (lane >= o) bs += t; }
        const float u = li - bs; float U = u;
#pragma unroll
        for (int o = 1; o < 64; o <<= 1) { const float t = lane_get(U, lane - o); if (lane >= o) U = fmaxf(U, t); }
        B2[64 * c + lane] = bs * LOG2E; U2[64 * c + lane] = u * LOG2E; UU[64 * c + lane] = U * LOG2E;
        if (lane == 63) { blast2[c] = bs * LOG2E; umax2[c] = U * LOG2E; }
    }
    __syncthreads();
    if (wid == 0) {
        const int c = lane & 31; const float bl = blast2[c], ml = bl + umax2[c]; float A = bl, B = ml;
#pragma unroll
        for (int o = 1; o < 32; o <<= 1) { const float Ap = lane_get(A, lane - o), Bp = lane_get(B, lane - o); if (c >= o) { B = fmaxf(Bp + A, B); A = Ap + A; } }
        const float mn = fmaxf(A, B); float mp = lane_get(mn, lane - 1); if (c == 0) mp = 0.f;
        if (lane < 32) { mprev2[c] = mp; decay[c] = exp2f(bl + mp - mn); wl[c] = exp2f(ml - mn); } }
    { *(LAS v4u*)((LAS bf16*)(L + O_Q) + lrow * QP + 8 * lc16) = q0_; *(LAS v4u*)((LAS bf16*)(L + O_K) + lrow * QP + 8 * lc16) = k0_; *(LAS v4u*)((LAS bf16*)(L + O_V) + lrow * VP + 8 * lc16) = v0_; }
    f32x4 Cst[5];
#pragma unroll
    for (int et = 0; et < 5; ++et) Cst[et] = (f32x4){0.f, 0.f, 0.f, 0.f};
    v2u ogc[4] = {{0u, 0u}, {0u, 0u}, {0u, 0u}, {0u, 0u}};
    const bf16* ogsrc = PROJ + (rb + 16 * (wid & 3) + fr) * NPROJ + 2304 + 64 * h + 4 * fq;
    if (wid < 4 && c_lo == 0) {
#pragma unroll
        for (int et = 0; et < 4; ++et) ogc[et] = *(const v2u*)(ogsrc + 16 * et); }
    __syncthreads();
#pragma unroll 1
    for (int c = 0; c < c_hi; ++c) {
        const bool full = c >= c_lo;
        const int cur = c & 1; LAS unsigned char* Lb = L + cur * BUF;
        const LAS bf16* Qs = (const LAS bf16*)(Lb + O_Q); const LAS bf16* Ks = (const LAS bf16*)(Lb + O_K); const LAS bf16* Vs = (const LAS bf16*)(Lb + O_V);
        LAS bf16* Ps = (LAS bf16*)(L + O_PS); const LAS bf16* Ctc = (const LAS bf16*)(L + O_CT + cur * CTB); LAS bf16* Ctn = (LAS bf16*)(L + O_CT + (cur ^ 1) * CTB);
        v4u nq, nk, nv; const bool more = c + 1 < c_hi;
        if (more) { const bf16* g2 = gsrc + (size_t)64 * (c + 1) * NPROJ; nq = *(const v4u*)(g2 + 1536); nk = *(const v4u*)(g2 + 1792); nv = *(const v4u*)(g2 + 2048); }
        const float mp2 = mprev2[c];
        if (full) { const int tt = wid >> 1, t = 16 * tt + fr; const float M2t = fmaxf(mp2, UU[64 * c + t]);
#pragma unroll
          for (int si = 0; si < 2; ++si) { const int st = 2 * (wid & 1) + si, s0 = 16 * st + 4 * fq; v2u w = {0u, 0u};
              if (st <= tt) { f32x4 acc = {0.f, 0.f, 0.f, 0.f};
#pragma unroll
                  for (int ks = 0; ks < 2; ++ks) { const bf16x8 a = *(const LAS bf16x8*)(Ks + (16 * st + fr) * QP + 32 * ks + 8 * fq), bq = *(const LAS bf16x8*)(Qs + (16 * tt + fr) * QP + 32 * ks + 8 * fq);
                      acc = __builtin_amdgcn_mfma_f32_16x16x32_bf16(a, bq, acc, 0, 0, 0); }
                  const f32x4 u4 = *(const LAS f32x4*)(U2 + 64 * c + s0); float p[4];
#pragma unroll
                  for (int e = 0; e < 4; ++e) p[e] = (s0 + e <= t) ? acc[e] * 0.125f * __builtin_amdgcn_exp2f(u4[e] - M2t) : 0.f;
                  w.x = pk2(p[0], p[1]); w.y = pk2(p[2], p[3]); }
              *(LAS v2u*)(Ps + t * QP + s0) = w; }
          __syncthreads(); }
        if (wid < 4) { if (full) {
            const int t = 16 * wid + fr; const size_t row = rb + 64 * c + t;
            f32x4 aP[5], aQ[5];
#pragma unroll
            for (int et = 0; et < 5; ++et) { aP[et] = (f32x4){0.f, 0.f, 0.f, 0.f}; aQ[et] = (f32x4){0.f, 0.f, 0.f, 0.f}; }
#pragma unroll
            for (int ks = 0; ks < 2; ++ks) {
                const bf16x8 bp = *(const LAS bf16x8*)(Ps + t * QP + 32 * ks + 8 * fq), bq = *(const LAS bf16x8*)(Qs + t * QP + 32 * ks + 8 * fq); bf16x8 av[5], ac[5];
#pragma unroll
                for (int et = 0; et < 5; ++et) { av[et] = trfrag(Vs, VP, 32 * ks, 16 * et, fr, fq); ac[et] = *(const LAS bf16x8*)(Ctc + (16 * et + fr) * QP + 32 * ks + 8 * fq); }
                __builtin_amdgcn_sched_barrier(0); asm volatile("s_waitcnt lgkmcnt(0)" ::: "memory"); __builtin_amdgcn_sched_barrier(0);
#pragma unroll
                for (int et = 0; et < 5; ++et) { aP[et] = __builtin_amdgcn_mfma_f32_16x16x32_bf16(av[et], bp, aP[et], 0, 0, 0); aQ[et] = __builtin_amdgcn_mfma_f32_16x16x32_bf16(ac[et], bq, aQ[et], 0, 0, 0); }
                __builtin_amdgcn_sched_barrier(0); }
            const float M2t = fmaxf(mp2, UU[64 * c + t]), inter8 = __builtin_amdgcn_exp2f(mp2 - M2t) * 0.125f, flo = __builtin_amdgcn_exp2f(-(B2[64 * c + t] + M2t));
            const float den = sum_fq(fq == 0 ? aP[4][0] + inter8 * aQ[4][0] : 0.f); const float dd = 1.f / fmaxf(fabsf(den), flo);
            f32x4 hv[4]; float ss = 0.f;
#pragma unroll
            for (int et = 0; et < 4; ++et) { hv[et] = (aP[et] + inter8 * aQ[et]) * dd; ss += (hv[et][0] * hv[et][0] + hv[et][1] * hv[et][1]) + (hv[et][2] * hv[et][2] + hv[et][3] * hv[et][3]); }
            ss = sum_fq(ss);
            const float rinv = rsqrtf(ss * (1.f / 64.f) + EPS);
#pragma unroll
            for (int et = 0; et < 4; ++et) { const f32x4 o4 = {bflo(ogc[et].x), bfhi(ogc[et].x), bflo(ogc[et].y), bfhi(ogc[et].y)}; f32x4 y;
#pragma unroll
                for (int e = 0; e < 4; ++e) y[e] = sigmoidf_(o4[e]) * hv[et][e] * rinv * gain4[et][e];
                v2u w; w.x = pk2(y[0], y[1]); w.y = pk2(y[2], y[3]); *(v2u*)(Y + row * YW + 512 + 64 * h + 16 * et + 4 * fq) = w; }
        } } else {
            const int dt = wid - 4; const float um = umax2[c], dc = decay[c], wlc = wl[c]; bf16x8 ak[2];
#pragma unroll
            for (int ks = 0; ks < 2; ++ks) { const bf16x8 kr = trfrag(Ks, QP, 32 * ks, 16 * dt, fr, fq); const f32x4 ua = *(const LAS f32x4*)(U2 + 64 * c + 32 * ks + 8 * fq), ub = *(const LAS f32x4*)(U2 + 64 * c + 32 * ks + 8 * fq + 4);
                float kw[8];
#pragma unroll
                for (int e = 0; e < 4; ++e) { kw[e] = bf2f((bf16)kr[e]) * __builtin_amdgcn_exp2f(ua[e] - um); kw[4 + e] = bf2f((bf16)kr[4 + e]) * __builtin_amdgcn_exp2f(ub[e] - um); }
                const v4u pk = {pk2(kw[0], kw[1]), pk2(kw[2], kw[3]), pk2(kw[4], kw[5]), pk2(kw[6], kw[7])}; ak[ks] = __builtin_bit_cast(bf16x8, pk); }
            bf16x8 vf[5][2];
#pragma unroll
            for (int et = 0; et < 5; ++et)
#pragma unroll
                for (int ks = 0; ks < 2; ++ks) vf[et][ks] = trfrag(Vs, VP, 32 * ks, 16 * et, fr, fq);
            __builtin_amdgcn_sched_barrier(0); asm volatile("s_waitcnt lgkmcnt(0)" ::: "memory"); __builtin_amdgcn_sched_barrier(0);
#pragma unroll
            for (int et = 0; et < 5; ++et) { f32x4 acc = {0.f, 0.f, 0.f, 0.f};
#pragma unroll
                for (int ks = 0; ks < 2; ++ks) acc = __builtin_amdgcn_mfma_f32_16x16x32_bf16(ak[ks], vf[et][ks], acc, 0, 0, 0);
                Cst[et] = Cst[et] * dc + acc * wlc;
                v2u w; w.x = pk2(Cst[et][0], Cst[et][1]); w.y = pk2(Cst[et][2], Cst[et][3]); *(LAS v2u*)(Ctn + (16 * et + fr) * QP + 16 * dt + 4 * fq) = w; }
        }
        if (more) { LAS unsigned char* Ln = L + (cur ^ 1) * BUF;
            *(LAS v4u*)((LAS bf16*)(Ln + O_Q) + lrow * QP + 8 * lc16) = nq; *(LAS v4u*)((LAS bf16*)(Ln + O_K) + lrow * QP + 8 * lc16) = nk; *(LAS v4u*)((LAS bf16*)(Ln + O_V) + lrow * VP + 8 * lc16) = nv; }
        if (wid < 4 && more && c + 1 >= c_lo) {
#pragma unroll
            for (int et = 0; et < 4; ++et) ogc[et] = *(const v2u*)(ogsrc + (size_t)64 * (c + 1) * NPROJ + 16 * et); }
        __syncthreads();
    }
}
}
__device__ __forceinline__ void mlstm_phase(LAS unsigned char* L, const bf16* PROJ, const float* SMALL, const float* ib, const float* fb, const float* hg, bf16* Y) {
    for (int u = blockIdx.x; u < BATCH * 4 * 4; u += gridDim.x) mls::unit(L, u >> 2, u & 3, PROJ, SMALL, ib, fb, hg, Y);
    __syncthreads();
}


namespace swa {
typedef short v4i16 __attribute__((ext_vector_type(4)));
constexpr int KP = 72, PP = 40;
constexpr int O_K = 0, O_V = 256 * KP * 2, O_P = 2 * O_V, PWB = 32 * PP * 2, O_BT = O_P + 8 * PWB, LDS_END = O_BT + 4 * 128 * 4;
static_assert(LDS_END <= 131072, "SWA LDS map");
__device__ __forceinline__ int t5_bucket(int n) { if (n < 16) return n; const int l = 16 + (int)(logf((float)n / 16.f) / logf(8.f) * 16.f); return l < 31 ? l : 31; }
__device__ __forceinline__ void unit(LAS unsigned char* L, int u, const bf16* PROJ, const float* relb, const float* sinks, bf16* Y) {
    const int tid = ltid(), lane = tid & 63, wid = __builtin_amdgcn_readfirstlane(tid >> 6), fr = lane & 15, fq = lane >> 4;
    const int b = u >> 5, kvh = (u >> 4) & 1, n = u & 15; const size_t rb = (size_t)b * SEQ;
    LAS bf16* Kb = (LAS bf16*)(L + O_K); LAS bf16* Vb = (LAS bf16*)(L + O_V); LAS bf16* Pw = (LAS bf16*)(L + O_P + wid * PWB); LAS float* BT = (LAS float*)(L + O_BT);
    bf16x8 qf[2][2][2];
#pragma unroll
    for (int tk = 0; tk < 2; ++tk) { const int task = 2 * wid + tk, hq_ = 4 * kvh + (task >> 2), i0_ = 32 * (task & 3);
#pragma unroll
        for (int qt = 0; qt < 2; ++qt)
#pragma unroll
            for (int ks = 0; ks < 2; ++ks) qf[tk][qt][ks] = *(const bf16x8*)(PROJ + (rb + 128 * n + i0_ + 16 * qt + fr) * NPROJ + 2560 + 64 * hq_ + 32 * ks + 8 * fq); }
    __syncthreads();
    BT[tid] = relb[t5_bucket(tid & 127) * 8 + 4 * kvh + (tid >> 7)] * LOG2E;
    v4u kb_[4], vb_[4];
#pragma unroll
    for (int i = 0; i < 4; ++i) { const int idx = tid + 512 * i, prow = idx >> 3, c16 = idx & 7, s = 128 * (n - 1) + prow; v4u kk, vv;
        { const bf16* g = PROJ + (rb + (s < 0 ? 0 : s)) * NPROJ + 64 * kvh + 8 * c16; kk = *(const v4u*)(g + 3072); vv = *(const v4u*)(g + 3200); }
        kb_[i] = kk; vb_[i] = vv; }
#pragma unroll
    for (int i = 0; i < 4; ++i) { const int idx = tid + 512 * i, prow = idx >> 3, c16 = idx & 7, s = 128 * (n - 1) + prow; const v4u z = {0u, 0u, 0u, 0u};
        *(LAS v4u*)(Kb + prow * KP + 8 * c16) = s < 0 ? z : kb_[i]; *(LAS v4u*)(Vb + prow * KP + 8 * c16) = s < 0 ? z : vb_[i]; }
    __syncthreads();
#pragma unroll
    for (int tk = 0; tk < 2; ++tk) {
        const int task = 2 * wid + tk, g = task >> 2, i0 = 32 * (task & 3), hq = 4 * kvh + g; const float sink2 = sinks[hq] * LOG2E;
        bf16x8 q[2][2];
#pragma unroll
        for (int qt = 0; qt < 2; ++qt)
#pragma unroll
            for (int ks = 0; ks < 2; ++ks) q[qt][ks] = qf[tk][qt][ks];
        f32x4 sc[2][10];
#pragma unroll
        for (int hb = 0; hb < 2; ++hb) {
            bf16x8 ka[5][2];
#pragma unroll
            for (int k5 = 0; k5 < 5; ++k5)
#pragma unroll
                for (int ks = 0; ks < 2; ++ks) ka[k5][ks] = *(const LAS bf16x8*)(Kb + (i0 + 16 * (5 * hb + k5) + fr) * KP + 32 * ks + 8 * fq);
            __builtin_amdgcn_sched_barrier(0); asm volatile("s_waitcnt lgkmcnt(0)" ::: "memory"); __builtin_amdgcn_sched_barrier(0);
#pragma unroll
            for (int k5 = 0; k5 < 5; ++k5) { const int kt = 5 * hb + k5;
                if (kt < 9) { sc[0][kt] = __builtin_amdgcn_mfma_f32_16x16x32_bf16(ka[k5][0], q[0][0], (f32x4){0.f, 0.f, 0.f, 0.f}, 0, 0, 0); sc[0][kt] = __builtin_amdgcn_mfma_f32_16x16x32_bf16(ka[k5][1], q[0][1], sc[0][kt], 0, 0, 0); }
                if (kt > 0) { sc[1][kt] = __builtin_amdgcn_mfma_f32_16x16x32_bf16(ka[k5][0], q[1][0], (f32x4){0.f, 0.f, 0.f, 0.f}, 0, 0, 0); sc[1][kt] = __builtin_amdgcn_mfma_f32_16x16x32_bf16(ka[k5][1], q[1][1], sc[1][kt], 0, 0, 0); } }
            __builtin_amdgcn_sched_barrier(0);
        }
        float linv[2];
        sc[0][9] = (f32x4){0.f, 0.f, 0.f, 0.f}; sc[1][0] = (f32x4){0.f, 0.f, 0.f, 0.f};
        if (n == 0) {
#pragma unroll
            for (int qt = 0; qt < 2; ++qt)
#pragma unroll
                for (int kt = 0; kt < 10; ++kt) if (kt - qt >= 0 && kt - qt <= 8)
#pragma unroll
                    for (int e = 0; e < 4; ++e) if (i0 + 16 * kt + 4 * fq + e < 128) sc[qt][kt][e] = -INFINITY;
        }
        const int D0 = 128 + fr - 4 * fq; const LAS float* bt = BT + g * 128;
#pragma unroll
        for (int qt = 0; qt < 2; ++qt) {
            float m = sink2;
#pragma unroll
            for (int kt = 0; kt < 10; ++kt) { const int dl = kt - qt; if (dl < 0 || dl > 8) continue;
#pragma unroll
                for (int e = 0; e < 4; ++e) { const int dist = D0 - 16 * dl - e; float x;
                    if (dl == 0) x = dist < 128 ? sc[qt][kt][e] + bt[dist & 127] : -INFINITY; else if (dl == 8) x = dist >= 0 ? sc[qt][kt][e] + bt[dist & 127] : -INFINITY; else x = sc[qt][kt][e] + bt[dist];
                    sc[qt][kt][e] = x; m = fmaxf(m, x); } }
            m = max_fq(m);
            float l = 0.f;
#pragma unroll
            for (int kt = 0; kt < 10; ++kt) { const int dl = kt - qt; if (dl < 0 || dl > 8) continue;
#pragma unroll
                for (int e = 0; e < 4; ++e) { const float pe = __builtin_amdgcn_exp2f(sc[qt][kt][e] - m); sc[qt][kt][e] = pe; l += pe; } }
            l = sum_fq(l); l += __builtin_amdgcn_exp2f(sink2 - m);
            linv[qt] = 1.f / l;
        }
        f32x4 o[2][4];
#pragma unroll
        for (int qt = 0; qt < 2; ++qt)
#pragma unroll
            for (int dt = 0; dt < 4; ++dt) o[qt][dt] = (f32x4){0.f, 0.f, 0.f, 0.f};
#pragma unroll
        for (int r = 0; r < 5; ++r) {
            v4i16 va[4], vb[4];
#pragma unroll
            for (int dt = 0; dt < 4; ++dt) { const LAS bf16* vp = Vb + (i0 + 32 * r + 8 * fq + (fr >> 2)) * KP + 16 * dt + 4 * (fr & 3);
                va[dt] = __builtin_amdgcn_ds_read_tr16_b64_v4i16((LAS v4i16*)vp); vb[dt] = __builtin_amdgcn_ds_read_tr16_b64_v4i16((LAS v4i16*)(vp + 4 * KP)); }
#pragma unroll
            for (int qt = 0; qt < 2; ++qt)
#pragma unroll
                for (int kk = 0; kk < 2; ++kk) { const f32x4 pv = sc[qt][2 * r + kk]; v2u w; w.x = pk2(pv[0], pv[1]); w.y = pk2(pv[2], pv[3]); *(LAS v2u*)(Pw + (16 * qt + fr) * PP + 16 * kk + 4 * fq) = w; }
            asm volatile("s_waitcnt lgkmcnt(0)" ::: "memory");
            const bf16x8 p0 = *(const LAS bf16x8*)(Pw + fr * PP + 8 * fq), p1 = *(const LAS bf16x8*)(Pw + (16 + fr) * PP + 8 * fq);
            __builtin_amdgcn_sched_barrier(0); asm volatile("s_waitcnt lgkmcnt(0)" ::: "memory"); __builtin_amdgcn_sched_barrier(0);
#pragma unroll
            for (int dt = 0; dt < 4; ++dt) { const bf16x8 av = {va[dt][0], va[dt][1], va[dt][2], va[dt][3], vb[dt][0], vb[dt][1], vb[dt][2], vb[dt][3]};
                o[0][dt] = __builtin_amdgcn_mfma_f32_16x16x32_bf16(av, p0, o[0][dt], 0, 0, 0); o[1][dt] = __builtin_amdgcn_mfma_f32_16x16x32_bf16(av, p1, o[1][dt], 0, 0, 0); }
            __builtin_amdgcn_sched_barrier(0);
        }
#pragma unroll
        for (int qt = 0; qt < 2; ++qt)
#pragma unroll
            for (int dt = 0; dt < 4; ++dt) { const f32x4 y = o[qt][dt] * linv[qt]; v2u w; w.x = pk2(y[0], y[1]); w.y = pk2(y[2], y[3]);
                *(v2u*)(Y + (rb + 128 * n + i0 + 16 * qt + fr) * YW + 768 + 64 * hq + 16 * dt + 4 * fq) = w; }
    }
}
}
__device__ __forceinline__ void swa_phase(LAS unsigned char* L, const bf16* PROJ, const float* relb, const float* sinks, bf16* Y) {
    for (int u = blockIdx.x; u < BATCH * 2 * 16; u += gridDim.x) swa::unit(L, u, PROJ, relb, sinks, Y);
    __syncthreads();
}
__device__ __forceinline__ void conv_chunk(const size_t idx, const bf16* PROJ, const float* cw, bf16* Y) {
    {
        const int cg = idx & 31; const size_t row0 = (idx >> 5) * 4; const int t0 = row0 % SEQ;
        v4u uu[6], cc[6], bb[4];
#pragma unroll
        for (int j = 0; j < 6; ++j) { const bool ok = t0 + j - 2 >= 0; const bf16* p = PROJ + (row0 + (ok ? j - 2 : 0)) * NPROJ + 8 * cg; uu[j] = *(const v4u*)(p + 768); cc[j] = *(const v4u*)(p + 1280);
            if (!ok) { uu[j] = (v4u){0u, 0u, 0u, 0u}; } }
#pragma unroll
        for (int j = 0; j < 4; ++j) bb[j] = *(const v4u*)(PROJ + (row0 + j) * NPROJ + 1024 + 8 * cg);
        f32x4 w[3][2];
#pragma unroll
        for (int k = 0; k < 3; ++k) { w[k][0] = *(const f32x4*)(cw + k * 256 + 8 * cg); w[k][1] = *(const f32x4*)(cw + k * 256 + 8 * cg + 4); }
        float z[6][8];
#pragma unroll
        for (int j = 0; j < 6; ++j) { z[j][0] = bflo(uu[j].x) * bflo(cc[j].x); z[j][1] = bfhi(uu[j].x) * bfhi(cc[j].x); z[j][2] = bflo(uu[j].y) * bflo(cc[j].y); z[j][3] = bfhi(uu[j].y) * bfhi(cc[j].y);
            z[j][4] = bflo(uu[j].z) * bflo(cc[j].z); z[j][5] = bfhi(uu[j].z) * bfhi(cc[j].z); z[j][6] = bflo(uu[j].w) * bflo(cc[j].w); z[j][7] = bfhi(uu[j].w) * bfhi(cc[j].w); }
#pragma unroll
        for (int j = 0; j < 4; ++j) { float a[8];
#pragma unroll
            for (int e = 0; e < 8; ++e) a[e] = w[0][e >> 2][e & 3] * z[j][e] + w[1][e >> 2][e & 3] * z[j + 1][e] + w[2][e >> 2][e & 3] * z[j + 2][e];
            v4u o; o.x = pk2(a[0] * bflo(bb[j].x), a[1] * bfhi(bb[j].x)); o.y = pk2(a[2] * bflo(bb[j].y), a[3] * bfhi(bb[j].y)); o.z = pk2(a[4] * bflo(bb[j].z), a[5] * bfhi(bb[j].z)); o.w = pk2(a[6] * bflo(bb[j].w), a[7] * bfhi(bb[j].w));
            *(v4u*)(Y + (row0 + j) * YW + 256 + 8 * cg) = o; }
    }
}
__device__ __forceinline__ void conv_phase(LAS unsigned char* lds, const bf16* PROJ, const float* cw, bf16* Y, unsigned* ticket) {
    constexpr unsigned NCH = (unsigned)((size_t)(M / 4) * 32 / 512);
    LAS unsigned* slot = (LAS unsigned*)(lds + MISC_OFF + 256);
    const int tid = ltid(); unsigned c = blockIdx.x;
    while (c < NCH) {
        unsigned nxt = 0u; if (tid == 0) nxt = __hip_atomic_fetch_add(ticket, 1u, __ATOMIC_RELAXED, __HIP_MEMORY_SCOPE_AGENT) + gridDim.x;
        conv_chunk((size_t)c * 512 + tid, PROJ, cw, Y);
        if (tid == 0) *slot = nxt;
        __syncthreads(); c = *slot; __syncthreads();
    }
}

__device__ __forceinline__ int colmap_in(int lc) {
    if (lc < 768) return lc;
    if (lc < 1536) return 772 + (lc - 768);
    if (lc < 2304) return 1540 + (lc - 1536);
    if (lc < 2560) return 2316 + (lc - 2304);
    if (lc < 3328) return 2572 + (lc - 2560);
    if (lc < 3332) return 768 + (lc - 3328);
    if (lc < 3340) return 2308 + (lc - 3332);
    if (lc < GATE0) return -1;
    return 3340 + (lc - GATE0);
}
struct TrItem { const float* W; const float* sc; unsigned char* WT; unsigned ldw, ldt; int srccol, n0, k0, f8; };
__device__ __forceinline__ void tr_load(const TrItem& d, float (&v)[32], float& scv, int lane) {
    scv = d.sc ? d.sc[d.k0 + lane] : 1.f;
    const int col = d.srccol < 0 ? 0 : d.srccol;
#pragma unroll
    for (int i = 0; i < 32; ++i) { const int kk = 2 * i + (lane >> 5); v[i] = d.W[(size_t)(d.k0 + kk) * d.ldw + col]; }
}
__device__ __forceinline__ void tr_store(const TrItem& d, const float (&v)[32], float scv, LAS float* scr, int lane) {
    scv *= d.f8 ? 64.f : 1.f; const bool hi = lane >= 32; const float zf = d.srccol < 0 ? 0.f : 1.f;
#pragma unroll
    for (int i = 0; i < 32; ++i) { const int kk = 2 * i + (lane >> 5); const float s0 = __int_as_float(__builtin_amdgcn_readlane(__float_as_int(scv), 2 * i)), s1 = __int_as_float(__builtin_amdgcn_readlane(__float_as_int(scv), 2 * i + 1)); scr[kk * 33 + (lane & 31)] = v[i] * ((hi ? s1 : s0) * zf); }
    asm volatile("s_waitcnt lgkmcnt(0)" ::: "memory");
    if (!d.f8) { const int c = lane & 7;
#pragma unroll
        for (int j = 0; j < 4; ++j) { const int n = (lane >> 3) + 8 * j; const LAS float* s = scr + (8 * c) * 33 + n;
            v4u o; o.x = pk2(s[0 * 33], s[1 * 33]); o.y = pk2(s[2 * 33], s[3 * 33]); o.z = pk2(s[4 * 33], s[5 * 33]); o.w = pk2(s[6 * 33], s[7 * 33]);
            *(v4u*)((bf16*)d.WT + (size_t)(d.n0 + n) * d.ldt + d.k0 + 8 * c) = o; } }
    else { const int c = lane & 3;
#pragma unroll
        for (int j = 0; j < 2; ++j) { const int n = (lane >> 2) + 16 * j; const LAS float* s = scr + (16 * c) * 33 + n;
            v4u o; o.x = pk4_f8(s[0 * 33], s[1 * 33], s[2 * 33], s[3 * 33]); o.y = pk4_f8(s[4 * 33], s[5 * 33], s[6 * 33], s[7 * 33]); o.z = pk4_f8(s[8 * 33], s[9 * 33], s[10 * 33], s[11 * 33]); o.w = pk4_f8(s[12 * 33], s[13 * 33], s[14 * 33], s[15 * 33]);
            *(v4u*)(d.WT + (size_t)(d.n0 + n) * D + d.k0 + 16 * c) = o; } }
    asm volatile("s_waitcnt lgkmcnt(0)" ::: "memory");
}

struct Args { const float* in[23]; float* out; unsigned char* ws; int ph_lo, ph_hi; };
#ifndef DUP_PH
#define DUP_PH -1
#endif
#define REPS(k) ((DUP_PH) == (k) ? 2 : 1)
#ifndef MK_PER_PHASE
#define MK_PER_PHASE 0
#endif

__device__ __forceinline__ const float* inp_(int i) { unsigned o = (unsigned)i * 8u; asm volatile("" : "+s"(o)); return *(const float* const __attribute__((address_space(4)))*)((const __attribute__((address_space(4))) char*)__builtin_amdgcn_kernarg_segment_ptr() + o); }
#define INP(i) inp_(i)
__device__ __forceinline__ unsigned char* kptr_(unsigned off) { asm volatile("" : "+s"(off)); return *(unsigned char* const __attribute__((address_space(4)))*)((const __attribute__((address_space(4))) char*)__builtin_amdgcn_kernarg_segment_ptr() + off); }
#define WSP() kptr_(192)
#define OUTP() ((float*)kptr_(184))
#define PTRS0 unsigned char* ws = WSP(); bf16 *XA = (bf16*)(ws + WS_XA), *XB = (bf16*)(ws + WS_XB), *Y = (bf16*)(ws + WS_Y), *PROJ = (bf16*)(ws + WS_PROJ), *ACT = (bf16*)(ws + WS_ACT); float *SMALL = (float*)(ws + WS_SMALL), *SSQ = (float*)(ws + WS_SSQ); const int G = gridDim.x; (void)XA; (void)XB; (void)Y; (void)PROJ; (void)ACT; (void)SMALL; (void)SSQ; (void)G
#define PTRS PTRS0; unsigned char* wl = ws + WS_W + (size_t)l * W_LAYER; const bf16 *WIN = (const bf16*)(wl + OFF_WIN), *WBR = (const bf16*)(wl + OFF_WBR), *WMO = (const bf16*)(wl + OFF_WMO), *WGU = (const bf16*)(wl + OFF_WGU), *WD = (const bf16*)(wl + OFF_WD); (void)WIN; (void)WBR; (void)WMO; (void)WGU; (void)WD
constexpr int TR_I_IN = 16 * (NIN / 32), TR_I_BR = 20 * 32, TR_I_MO = 16 * 32, TR_I_GU = 16 * (2 * DFF / 32), TR_I_D = 44 * 32, TR_I_L = TR_I_IN + TR_I_BR + TR_I_MO + TR_I_GU + TR_I_D;
__device__ __forceinline__ TrItem tr_decode(int it, int lane, unsigned char* ws) {
    TrItem d; const int l = it / TR_I_L; int r = it % TR_I_L; unsigned char* wl = ws + WS_W + (size_t)l * W_LAYER; d.f8 = 0; d.sc = nullptr;
    if (r < TR_I_IN) { const int kb = r / (NIN / 32), nb = r % (NIN / 32); d.srccol = colmap_in(32 * nb + (lane & 31)); d.W = INP(3) + (size_t)l * D * IN_COLS; d.ldw = IN_COLS; d.sc = INP(2) + l * D; d.k0 = 64 * kb;
        if (32 * nb >= GATE0) { d.f8 = 1; d.WT = ws + WS_W8 + (size_t)l * 4 * MiB; d.ldt = D; d.n0 = 32 * nb - GATE0; }
        else { d.WT = wl + OFF_WIN; d.ldt = D; d.n0 = 32 * nb; }
        return d; } r -= TR_I_IN;
    if (r < TR_I_BR) { const int kb = r / 32, nb = r % 32; const int k0 = 64 * kb; const float* W; int kk0;
        if (k0 < 256) { W = INP(14) + (size_t)l * 256 * D; kk0 = k0; } else if (k0 < 512) { W = INP(15) + (size_t)l * 256 * D; kk0 = k0 - 256; }
        else if (k0 < 768) { W = INP(16) + (size_t)l * 256 * D; kk0 = k0 - 512; } else { W = INP(17) + (size_t)l * 512 * D; kk0 = k0 - 768; }
        d.W = W + (size_t)kk0 * D - (size_t)k0 * D; d.ldw = D; d.srccol = 32 * nb + (lane & 31); d.WT = wl + OFF_WBR; d.ldt = YW; d.n0 = 32 * nb; d.k0 = k0; return d; } r -= TR_I_BR;
    if (r < TR_I_MO) { const int kb = r / 32, nb = r % 32;
        d.W = INP(18) + (size_t)l * D * D; d.ldw = D; d.srccol = 32 * nb + (lane & 31); d.WT = wl + OFF_WMO; d.ldt = D; d.n0 = 32 * nb; d.k0 = 64 * kb; return d; } r -= TR_I_MO;
    if (r < TR_I_GU) { const int kb = r / (2 * DFF / 32), nb = r % (2 * DFF / 32); const int n = 32 * nb, pn = n / 256, rr = n % 256, wc = rr / 64, bj = (rr % 64) / 32;
        d.W = (bj ? INP(21) : INP(20)) + (size_t)l * D * DFF; d.ldw = DFF; d.srccol = 128 * pn + 32 * wc + (lane & 31); d.sc = INP(19) + l * D; d.WT = wl + OFF_WGU; d.ldt = D; d.n0 = n; d.k0 = 64 * kb; return d; } r -= TR_I_GU;
    { const int kb = r / 32, nb = r % 32;
        d.W = INP(22) + (size_t)l * DFF * D; d.ldw = D; d.srccol = 32 * nb + (lane & 31); d.WT = wl + OFF_WD; d.ldt = DFF; d.n0 = 32 * nb; d.k0 = 64 * kb; return d; }
}
__device__ __forceinline__ void tr_weights(LAS unsigned char* lds, unsigned char* ws, int it0, int it1, int gw, int NGW, int wave, int lane) {
    LAS float* scr = (LAS float*)(lds + wave * 16384);
    float va[32], vb[32], sa = 1.f, sb = 1.f; TrItem da, db; int it = it0 + gw;
    if (it < it1) { da = tr_decode(it, lane, ws); tr_load(da, va, sa, lane); }
#pragma unroll 1
    for (; it < it1; it += 2 * NGW) {
        const bool hb = it + NGW < it1; if (hb) { db = tr_decode(it + NGW, lane, ws); tr_load(db, vb, sb, lane); }
        tr_store(da, va, sa, scr, lane);
        const bool ha = it + 2 * NGW < it1; if (ha) { da = tr_decode(it + 2 * NGW, lane, ws); tr_load(da, va, sa, lane); }
        if (hb) tr_store(db, vb, sb, scr, lane);
    }
}
__global__ void __launch_bounds__(NWAVES * 64, 2) fwd(Args args) {
    extern __shared__ __attribute__((aligned(16))) unsigned char lds_[];
    LAS unsigned char* lds = (LAS unsigned char*)lds_;
    { const int tid = threadIdx.x;
      for (int u = tid; u < (LDS_BYTES - LDSCTL_OFF) / 4; u += NWAVES * 64) ((LAS unsigned*)(lds + LDSCTL_OFF))[u] = 0u;
      __syncthreads();
      if ((tid & 63) == 0) ((LAS int*)(lds + WTAB_OFF))[hwkey_()] = tid >> 6; }
    __syncthreads();
    (void)xcd_barrier_post((unsigned*)(WSP() + WS_CTL) + CW_BAR, (volatile LAS unsigned*)(lds + MISC_OFF) + 8);
#define IN(k) (args.ph_lo <= (k) && (k) < args.ph_hi)
#define SEAM(k) do { if (IN(k) && IN((k) + 1)) { XcdBarrier b_; b_.bar = (unsigned*)(WSP() + WS_CTL) + CW_BAR; b_.x = xb_xcc_id(); b_.st = (volatile LAS unsigned*)(lds + MISC_OFF) + 8; for (int rb_ = 0; rb_ < REPS(50); ++rb_) xcd_barrier(b_); } } while (0)
    if (IN(0)) for (int rep_ = 0; rep_ < REPS(100); ++rep_) { PTRS0;
        const int tid = ltid(), lane = tid & 63, wave = __builtin_amdgcn_readfirstlane(tid >> 6); (void)tid;
        LAS float* scr = (LAS float*)(lds + wave * 16384);
        const int gw = blockIdx.x * NWAVES + wave, NGW = G * NWAVES;
        tr_weights(lds, ws, 0, DEPTH * TR_I_L, gw, NGW, wave, lane);
#pragma unroll 1
        for (int m0 = gw; m0 < M; m0 += 4 * NGW) {
            f32x4 v[4][4];
#pragma unroll
            for (int r = 0; r < 4; ++r) { const int m = m0 + r * NGW; if (m < M) { const f32x4* xr = (const f32x4*)(INP(0) + (size_t)m * D) + lane;
#pragma unroll
                for (int j = 0; j < 4; ++j) v[r][j] = xr[64 * j]; } }
#pragma unroll
            for (int r = 0; r < 4; ++r) { const int m = m0 + r * NGW; if (m < M) { float s = 0.f; v2u* o8 = (v2u*)(XA + (size_t)m * D) + lane; unsigned* o4 = (unsigned*)((unsigned char*)OUTP() + OUT_XA8 + (size_t)m * D) + lane;
#pragma unroll
                for (int j = 0; j < 4; ++j) { const f32x4 x = v[r][j]; s += (x.x * x.x + x.y * x.y) + (x.z * x.z + x.w * x.w); v2u w; w.x = pk2(x.x, x.y); w.y = pk2(x.z, x.w); o8[64 * j] = w; o4[64 * j] = pk4_f8(x.x, x.y, x.z, x.w); }
#pragma unroll
                for (int o = 1; o < 16; o <<= 1) s += lane_get(s, lane ^ o);
                s = sum_fq(s);
                if (lane < 4) SSQ[(size_t)m * 4 + lane] = lane == 0 ? s : 0.f; } }
        }
    }
    SEAM(0);

#pragma unroll 1
    for (int l = 0; l < DEPTH; ++l) {
        const int pb = 1 + 6 * l;
        if (IN(pb)) for (int rep_ = 0; rep_ < REPS(0); ++rep_) { PTRS; pg8::Gemm g{XA, WIN, M, NMIX, D, D, D}; pg8::StaticOrder S; S.init(M, NMIX, G, (int)blockIdx.x);
          pg8::EpiP1 E{PROJ, SMALL, SSQ, INP(5) + l * 64, INP(6) + l * 64, INP(11) + l * 64, INP(12) + l * 64};
          pg8::gemm_phase<pg8::EpiP1, pg8::StaticOrder, true, true>(lds, g, S, E); }
        SEAM(pb);
        if (IN(pb + 1)) for (int rep_ = 0; rep_ < REPS(1); ++rep_) { PTRS;
          for (int r2 = 0; r2 < REPS(11); ++r2) fox_phase((char*)lds_, PROJ, SMALL, INP(4) + l * 4, Y); for (int r2 = 0; r2 < REPS(12); ++r2) swa_phase(lds, PROJ, INP(1), INP(13) + l * 8, Y); __syncthreads(); for (int r2 = 0; r2 < REPS(14); ++r2) mlstm_phase(lds, PROJ, SMALL, INP(8) + l * 4, INP(9) + l * 4, INP(10) + l * 256, Y); __syncthreads(); conv_phase(lds, PROJ, INP(7) + l * 768, Y, (unsigned*)(ws + WS_CTL) + 8192 + 64 * l); __syncthreads(); }
        SEAM(pb + 1);
        if (IN(pb + 2)) for (int rep_ = 0; rep_ < REPS(2); ++rep_) { PTRS; pg8::Gemm g{(const bf16*)((const unsigned char*)OUTP() + OUT_XA8), (const bf16*)(ws + WS_W8 + (size_t)l * 4 * MiB), M, 4096, D / 2, D / 2, D / 2};
          pg8::EpiGateS E{(pg8::u32x4*)(ws + WS_SLAB) + (size_t)blockIdx.x * 32768, SSQ};
          const int xcd = (int)blockIdx.x & 7, jw = (int)blockIdx.x >> 3, per = G >> 3;
#pragma unroll 1
          for (int idx = jw; idx < 64; idx += per) { const int pm_ = 16 * xcd + (idx >> 2), pp_ = idx & 3; const pg8::FourUnit s4{pm_, pp_};
              { const int t_ = ltid(); if (t_ < pg8::BM) ((LAS float*)(lds + pg8::RT_OFF))[t_] = rstd_of(SSQ, pm_ * pg8::BM + t_) * (-LOG2E / 64.f); __syncthreads(); }
              for (int r2 = 0; r2 < REPS(21); ++r2) pg8::gemm_phase<pg8::EpiGateS, pg8::FourUnit, true, true, 1, true>(lds, g, s4, E); for (int r2 = 0; r2 < REPS(22); ++r2) pg8::merge_gemm(lds, pm_, pp_, Y, WBR, XB, E.slab); if (DUP_PH == 23) pg8::merge_gemm<true>(lds, pm_, pp_, Y, WBR, (bf16*)OUTP(), E.slab); } }
        SEAM(pb + 2);
        if (IN(pb + 3)) { PTRS; pg8::Gemm g{XB, WMO, M, D, D, D, D}; pg8::StaticOrder S; S.init(M, D, G, (int)blockIdx.x);
          pg8::EpiRes E{XA, nullptr, SSQ, nullptr};
          pg8::gemm_phase<pg8::EpiRes, pg8::StaticOrder, true, true>(lds, g, S, E); }
        SEAM(pb + 3);
        if (IN(pb + 4)) for (int rep_ = 0; rep_ < REPS(4); ++rep_) { PTRS; pg8::Gemm g{XA, WGU, M, 2 * DFF, D, D, D}; pg8::StaticOrder S; S.init(M, 2 * DFF, G, (int)blockIdx.x);
          pg8::EpiFFN E{ACT, SSQ};
          pg8::gemm_phase<pg8::EpiFFN, pg8::StaticOrder, true, true>(lds, g, S, E); }
        SEAM(pb + 4);
        if (IN(pb + 5)) { PTRS; pg8::Gemm g{ACT, WD, M, D, DFF, DFF, DFF}; pg8::StaticOrder S; S.init(M, D, G, (int)blockIdx.x);
          pg8::EpiRes E{XA, l == DEPTH - 1 ? OUTP() : nullptr, l == DEPTH - 1 ? nullptr : SSQ, l == DEPTH - 1 ? nullptr : (unsigned char*)OUTP() + OUT_XA8};
          pg8::gemm_phase<pg8::EpiRes, pg8::StaticOrder, true, true>(lds, g, S, E); }
        if (l < DEPTH - 1) SEAM(pb + 5);
    }
}

extern "C" void kernel_launch(void* const* d_in, const int* in_sizes, int n_in, void* d_out, int out_size, void* d_ws, size_t ws_size, hipStream_t stream) {
    static int grid = 0;
    if (grid == 0) {
        if (n_in != 23 || ws_size < WS_END || out_size != M * D || in_sizes[0] != M * D) { fprintf(stderr, "kernel_launch: unexpected shapes n_in %d ws %zu out %d\n", n_in, ws_size, out_size); grid = -1; return; }
        int dev = 0, cus = 0, per_cu = 0;
        if (hipGetDevice(&dev) != hipSuccess || hipDeviceGetAttribute(&cus, hipDeviceAttributeMultiprocessorCount, dev) != hipSuccess) { grid = -1; return; }
        if (hipFuncSetAttribute((const void*)fwd, hipFuncAttributeMaxDynamicSharedMemorySize, LDS_BYTES) != hipSuccess) { fprintf(stderr, "kernel_launch: hipFuncSetAttribute failed\n"); grid = -1; return; }
        if (hipOccupancyMaxActiveBlocksPerMultiprocessor(&per_cu, (const void*)fwd, NWAVES * 64, LDS_BYTES) != hipSuccess || per_cu < 1) fprintf(stderr, "kernel_launch: occupancy query reports %d\n", per_cu);
        (void)hipGetLastError();
        grid = cus;
    }
    if (grid < 0) return;
    if (hipMemsetAsync((char*)d_ws + WS_CTL, 0, CTL_ZERO_BYTES, stream) != hipSuccess) return;
    Args a{};
    for (int i = 0; i < 23; ++i) a.in[i] = (const float*)d_in[i];
    a.out = (float*)d_out; a.ws = (unsigned char*)d_ws;
    constexpr int NPH = 1 + 6 * DEPTH;
    if (MK_PER_PHASE) { for (int p = 0; p < NPH; ++p) { a.ph_lo = p; a.ph_hi = p + 1; hipLaunchKernelGGL(fwd, dim3(grid), dim3(NWAVES * 64), LDS_BYTES, stream, a); } }
    else { a.ph_lo = 0; a.ph_hi = NPH; hipLaunchKernelGGL(fwd, dim3(grid), dim3(NWAVES * 64), LDS_BYTES, stream, a); }
}
```

```cpp
#include <hip/hip_runtime.h>
#include <cstdio>
#include <cstdint>
#include <hip/hip_bf16.h>
#include <cmath>

typedef unsigned short bf16;
constexpr int BATCH = 16, SEQ = 2048, D = 1024, M = BATCH * SEQ, DEPTH = 2;
constexpr int IN_COLS = 7436, NPROJ = 3328, NMIX = 3584, NIN = 7680, GATE0 = 3584, DFF = 2816, YW = 1280;
constexpr float EPS = 1e-6f, LOG2E = 1.4426950408889634f, C2 = 0.125f * LOG2E;
constexpr size_t MiB = 1u << 20;
constexpr size_t WS_CTL = 0, CTL_ZERO_BYTES = 64 * 1024;
constexpr size_t WS_W = 1 * MiB, W_LAYER = 36 * MiB;
constexpr size_t OFF_WIN = 0, OFF_WBR = 15 * MiB, OFF_WMO = OFF_WBR + 2560 * 1024, OFF_WGU = OFF_WMO + 2 * MiB, OFF_WD = OFF_WGU + 11 * MiB;
constexpr size_t WS_XA = 73 * MiB, WS_XB = 137 * MiB, WS_SMALL = 201 * MiB, WS_SSQ = 203 * MiB, WS_Y = 208 * MiB, WS_PROJ = 288 * MiB, WS_ACT = 288 * MiB, WS_W8 = 496 * MiB, WS_END = 504 * MiB;
constexpr size_t WS_SLAB = WS_PROJ  ;
constexpr size_t OUT_XA8 = 64 * MiB;
constexpr int CW_BAR = 4096;
constexpr int RING_BYTES = 131072, LDSCTL_OFF = RING_BYTES, MISC_OFF = LDSCTL_OFF + 320, LDS_BYTES = 147456;
constexpr int NWAVES = 8;

#define GAS __attribute__((address_space(1)))
#define LAS __attribute__((address_space(3)))
typedef unsigned v4u __attribute__((ext_vector_type(4)));
typedef unsigned v2u __attribute__((ext_vector_type(2)));
typedef float f32x4 __attribute__((ext_vector_type(4)));
typedef short bf16x8 __attribute__((ext_vector_type(8)));
typedef GAS unsigned gu32;

__device__ __forceinline__ float bf2f(bf16 v) { return __uint_as_float((unsigned)v << 16); }
__device__ __forceinline__ float bflo(unsigned w) { return __uint_as_float(w << 16); }
__device__ __forceinline__ float bfhi(unsigned w) { return __uint_as_float(w & 0xffff0000u); }
__device__ __forceinline__ unsigned f2bf(float f) { unsigned u = __float_as_uint(f); return (u + 0x7fffu + ((u >> 16) & 1u)) >> 16; }
typedef float f32x2_g __attribute__((ext_vector_type(2))); typedef __bf16 bf16x2_g __attribute__((ext_vector_type(2)));
__device__ __forceinline__ unsigned pk2(float lo, float hi) { f32x2_g t = {lo, hi}; bf16x2_g b = __builtin_convertvector(t, bf16x2_g); return __builtin_bit_cast(unsigned, b); }
__device__ __forceinline__ unsigned pk4_f8(float a, float b, float c, float d) {
    a = __builtin_fminf(__builtin_fmaxf(a, -448.f), 448.f); b = __builtin_fminf(__builtin_fmaxf(b, -448.f), 448.f); c = __builtin_fminf(__builtin_fmaxf(c, -448.f), 448.f); d = __builtin_fminf(__builtin_fmaxf(d, -448.f), 448.f);
    int w = __builtin_amdgcn_cvt_pk_fp8_f32(a, b, 0, false); w = __builtin_amdgcn_cvt_pk_fp8_f32(c, d, w, true); return (unsigned)w; }
__device__ __forceinline__ float sigmoidf_(float x) { return __builtin_amdgcn_rcpf(1.f + __builtin_amdgcn_exp2f(-LOG2E * x)); }
__device__ __forceinline__ float logsigmoidf_(float x) { return fminf(x, 0.f) - 0.6931471805599453f * __builtin_amdgcn_logf(1.f + __builtin_amdgcn_exp2f(-LOG2E * fabsf(x))); }
constexpr int WTAB_OFF = LDSCTL_OFF + 1024;
extern __shared__ __attribute__((aligned(16))) unsigned char lds_g_[];
__device__ __forceinline__ unsigned hwkey_() { return (unsigned)__builtin_amdgcn_s_getreg((5 << 11) | 4) & 0x3fu; }
__device__ __forceinline__ int ltid() {
    const int wave = __builtin_amdgcn_readfirstlane(((const LAS int*)((LAS unsigned char*)lds_g_ + WTAB_OFF))[hwkey_()]);
    int ln; asm volatile("v_mbcnt_lo_u32_b32 %0, -1, 0\n\tv_mbcnt_hi_u32_b32 %0, -1, %0" : "=&v"(ln));
    int t = wave * 64 + ln; asm volatile("" : "+v"(t)); return t; }
__device__ __forceinline__ float sum_x16(float x) { const auto r = __builtin_amdgcn_permlane16_swap(__float_as_uint(x), __float_as_uint(x), false, false); return __uint_as_float(r[0]) + __uint_as_float(r[1]); }
__device__ __forceinline__ float sum_x32(float x) { const auto r = __builtin_amdgcn_permlane32_swap(__float_as_uint(x), __float_as_uint(x), false, false); return __uint_as_float(r[0]) + __uint_as_float(r[1]); }
__device__ __forceinline__ float max_x16(float x) { const auto r = __builtin_amdgcn_permlane16_swap(__float_as_uint(x), __float_as_uint(x), false, false); return fmaxf(__uint_as_float(r[0]), __uint_as_float(r[1])); }
__device__ __forceinline__ float max_x32(float x) { const auto r = __builtin_amdgcn_permlane32_swap(__float_as_uint(x), __float_as_uint(x), false, false); return fmaxf(__uint_as_float(r[0]), __uint_as_float(r[1])); }
__device__ __forceinline__ float sum_fq(float x) { return sum_x32(sum_x16(x)); }
__device__ __forceinline__ float max_fq(float x) { return max_x32(max_x16(x)); }
__device__ __forceinline__ float lane_get(float x, int src_lane) { return __int_as_float(__builtin_amdgcn_ds_bpermute(src_lane << 2, __float_as_int(x))); }
__device__ __forceinline__ float rstd_of(const float* ssq, int row) {
    const f32x4 a = *(const f32x4*)(ssq + (size_t)row * 4);
    return rsqrtf(((a.x + a.y) + (a.z + a.w)) * (1.f / D) + EPS);
}
constexpr int RED_OFF = LDSCTL_OFF + 4096;

namespace pg8 {
#define PG8_LAS __attribute__((address_space(3)))
typedef unsigned short bf16_t;
typedef short bf16x8 __attribute__((ext_vector_type(8)));
typedef float f32x4 __attribute__((ext_vector_type(4)));
typedef unsigned u32x4 __attribute__((ext_vector_type(4)));
typedef int v4i32_ __attribute__((ext_vector_type(4))); typedef int v8i32_ __attribute__((ext_vector_type(8)));
constexpr int BM = 256, BK = 64, HALF = 128, HTB = HALF * BK * 2  , STAGE_BYTES = 8 * HTB, NXCD = 8, WGM = 2;

__host__ __device__ __forceinline__ int lds_byte(int r, int c) { const int st = (r >> 4) * 2 + (c >> 5), rr = r & 15, cc = c & 31, ob = rr * 64 + cc * 2; return st * 1024 + (ob ^ (((ob >> 9) & 1) << 5)); }
__host__ __device__ __forceinline__ void stage_rc(int b, int& R, int& C) { const int st = b / 1024, sb = b % 1024, swz = sb ^ (((sb >> 9) & 1) << 5); R = (st >> 1) * 16 + swz / 64; C = (st & 1) * 32 + (swz % 64) / 2; }
__host__ __device__ __forceinline__ int perm32(int rho) { const int n = rho >> 4, i = rho & 15; return 8 * (i >> 2) + 4 * n + (i & 3); }

struct Unit { int pm, pn; };

struct StaticOrder {
    int nM, nN, nwg, G, c;
    __host__ __device__ void init(int M, int N, int G_, int c_) { nM = M / BM; nN = N / BM; nwg = nM * nN; G = G_; c = c_; }
    __host__ __device__ bool next(int i, Unit& u) const {
        const long L = (long)i * G + c; if (L >= nwg) return false;
        int wgid = (int)L; { const int q = nwg / NXCD, r = nwg % NXCD, xcd = wgid % NXCD, off = wgid / NXCD; wgid = (xcd < r ? xcd * (q + 1) : r * (q + 1) + (xcd - r) * q) + off; }
        const int nig = WGM * nN, gid = wgid / nig, fm = gid * WGM, gsz = (nM - fm) < WGM ? (nM - fm) : WGM;
        u.pm = fm + ((wgid % nig) % gsz); u.pn = (wgid % nig) / gsz; return true;
    }
    __device__ __forceinline__ void a_ready(const Unit&) const {}
    __device__ __forceinline__ void done(const Unit&) const {}
};
struct Gemm { const bf16_t* A; const bf16_t* Bt; int M, N, K, lda, ldb; };
typedef float f32x2_t __attribute__((ext_vector_type(2))); typedef __bf16 bf16x2_t __attribute__((ext_vector_type(2)));
__device__ __forceinline__ unsigned cvt_pk_bf16(float lo, float hi) { f32x2_t v = {lo, hi}; bf16x2_t b = __builtin_convertvector(v, bf16x2_t); return __builtin_bit_cast(unsigned, b); }
__device__ __forceinline__ u32x4 pack8(const f32x4 a, const f32x4 b) { u32x4 w; w.x = cvt_pk_bf16(a[0], a[1]); w.y = cvt_pk_bf16(a[2], a[3]); w.z = cvt_pk_bf16(b[0], b[1]); w.w = cvt_pk_bf16(b[2], b[3]); return w; }

struct RowPf { };
constexpr int RT_OFF = LDSCTL_OFF + 8192, RED_OFF_ = LDSCTL_OFF + 4096;
__device__ __forceinline__ void pf_rows(RowPf&, const float* ssq, const Unit& u, int wr, int fr, int tid) {
    if (wr == 0) { const int wq = __builtin_amdgcn_readfirstlane(tid >> 6);
        __builtin_amdgcn_global_load_lds((const unsigned*)(ssq + (size_t)(u.pm * BM + tid) * 4), (PG8_LAS unsigned*)((PG8_LAS unsigned char*)lds_g_ + RED_OFF_ + wq * 1024), 16, 0, 0); } }
__device__ __forceinline__ void pf_publish(const RowPf& pf, int tid) {
    PG8_LAS float* RT = (PG8_LAS float*)((PG8_LAS unsigned char*)lds_g_ + RT_OFF);
    asm volatile("s_waitcnt vmcnt(16)" ::: "memory");
    if (tid < BM) { const f32x4 v = *(const PG8_LAS f32x4*)((PG8_LAS unsigned char*)lds_g_ + RED_OFF_ + tid * 16); RT[tid] = rsqrtf(((v.x + v.y) + (v.z + v.w)) * (1.f / D) + EPS); }
    asm volatile("s_waitcnt lgkmcnt(0)" ::: "memory"); __builtin_amdgcn_s_barrier(); asm volatile("" ::: "memory");
}
__device__ __forceinline__ float pf_rstd(int ai, int wr, int m, int fr) { return ((const PG8_LAS float*)((PG8_LAS unsigned char*)lds_g_ + RT_OFF))[ai * HALF + wr * 64 + m * 16 + fr]; }

struct EpiP1 {
    static constexpr bool AFTER_DRAIN = false;
    bf16_t* proj; float* small; const float* ssq; const float *fqg, *fkg, *sqg, *skg;
    __device__ __forceinline__ void prefetch(RowPf& pf, const Unit& u, int wr, int fr, int tid) const { pf_rows(pf, ssq, u, wr, fr, tid); }
    __device__ __forceinline__ void operator()(const f32x4 (&acc)[2][2][4][2], const Unit& u, int wr, int wc, int fr, int fq, const RowPf& pf) const {
        pf_publish(pf, (wr * 4 + wc) * 64 + fq * 16 + fr);
        const int pn = u.pn; const float* gain = nullptr; float sc = 1.f;
        if (pn == 0) { gain = fqg; sc = C2; } else if (pn == 1) gain = fkg; else if (pn == 10 || pn == 11) { gain = sqg; sc = C2; } else if (pn == 12 && wc < 2) gain = skg;
        f32x4 gv[2][2];
#pragma unroll
        for (int bj = 0; bj < 2; ++bj)
#pragma unroll
            for (int n = 0; n < 2; ++n) gv[bj][n] = gain ? *(const f32x4*)(gain + 32 * bj + 8 * fq + 4 * n) : (f32x4){1.f, 1.f, 1.f, 1.f};
#pragma unroll
        for (int ai = 0; ai < 2; ++ai)
#pragma unroll
            for (int m = 0; m < 4; ++m) {
                const int row = u.pm * BM + ai * HALF + wr * 64 + m * 16 + fr; const float r = pf_rstd(ai, wr, m, fr);
                f32x4 v[2][2];
#pragma unroll
                for (int bj = 0; bj < 2; ++bj)
#pragma unroll
                    for (int n = 0; n < 2; ++n) v[bj][n] = acc[ai][bj][m][n] * r;
                if (gain) {
                    float ss = 0.f;
#pragma unroll
                    for (int bj = 0; bj < 2; ++bj)
#pragma unroll
                        for (int n = 0; n < 2; ++n) { const f32x4 x = v[bj][n]; ss += (x[0] * x[0] + x[1] * x[1]) + (x[2] * x[2] + x[3] * x[3]); }
                    ss = sum_fq(ss);
                    const float rinv = rsqrtf(ss * (1.f / 64.f) + EPS) * sc;
#pragma unroll
                    for (int bj = 0; bj < 2; ++bj)
#pragma unroll
                        for (int n = 0; n < 2; ++n) v[bj][n] = v[bj][n] * rinv * gv[bj][n];
                }
                if (pn == 13) {
                    if (wc == 0) { if (fq == 0) { *(f32x4*)(small + (size_t)row * 16) = v[0][0]; *(f32x4*)(small + (size_t)row * 16 + 4) = v[0][1]; } else if (fq == 1) *(f32x4*)(small + (size_t)row * 16 + 8) = v[0][0]; }
                } else {
                    bf16_t* o = proj + (size_t)row * NPROJ + pn * BM + wc * 64 + 8 * fq;
                    *(u32x4*)(o) = pack8(v[0][0], v[0][1]); *(u32x4*)(o + 32) = pack8(v[1][0], v[1][1]);
                }
            }
    }
};
struct FourUnit { int pm, pp; __device__ __forceinline__ bool next(int i, Unit& o) const { if (i > 3) return false; o.pm = pm; o.pn = 4 * pp + i; return true; } __device__ __forceinline__ void a_ready(const Unit&) const {} __device__ __forceinline__ void done(const Unit&) const {} };
struct EpiGateS {
    static constexpr bool AFTER_DRAIN = false;
    u32x4* slab; const float* ssq;
    __device__ __forceinline__ void prefetch(RowPf&, const Unit&, int, int, int) const {}
    __device__ __forceinline__ void operator()(const f32x4 (&acc)[2][2][4][2], const Unit& u, int, int, int, int, const RowPf&) const {
        typedef unsigned u32x2 __attribute__((ext_vector_type(2)));
        const int t_ = ltid(), wid_ = __builtin_amdgcn_readfirstlane(t_ >> 6), wr = wid_ >> 2, wc = wid_ & 3, fr = t_ & 15, fq = (t_ >> 4) & 3;
        unsigned vo = (unsigned)((wr * 4 + wc) * 8192 + (fq * 16 + fr) * 16); asm volatile("" : "+v"(vo));
        unsigned char* sb = (unsigned char*)(slab + (u.pn & 3) * 128);
        float rr[2][4];
#pragma unroll
        for (int ai = 0; ai < 2; ++ai)
#pragma unroll
            for (int m = 0; m < 4; ++m) rr[ai][m] = pf_rstd(ai, wr, m, fr);
#pragma unroll
        for (int ai = 0; ai < 2; ++ai)
#pragma unroll
            for (int m = 0; m < 4; ++m) {
                f32x4 d[4];
#pragma unroll
                for (int s = 0; s < 4; ++s) { const f32x4 xs = acc[ai][s >> 1][m][s & 1] * rr[ai][m];
#pragma unroll
                    for (int e = 0; e < 4; ++e) d[s][e] = 1.f + __builtin_amdgcn_exp2f(fminf(fmaxf(xs[e], -43.28f), 43.28f)); }
#pragma unroll
                for (int s = 0; s < 4; ++s) { f32x4 q;
#pragma unroll
                    for (int e = 0; e < 4; ++e) { const float iv = __builtin_amdgcn_rcpf(d[s][e]); q[e] = s < 3 ? d[s < 3 ? s + 1 : 3][e] * iv : iv; }
                    u32x2 w; w.x = cvt_pk_bf16(q[0], q[1]); w.y = cvt_pk_bf16(q[2], q[3]);
                    *(u32x2*)(sb + (size_t)((s * 2 + ai) * 65536 + (m >> 1) * 1024 + (m & 1) * 8) + vo) = w; }
                asm volatile("" ::: "memory"); __builtin_amdgcn_sched_barrier(0); }
    }
};
template <bool NOB = false>
__device__ __forceinline__ void merge_gemm(PG8_LAS unsigned char* lds, const int pm, const int pn, const bf16_t* y, const bf16_t* wbr, bf16_t* xb, const u32x4* slab) {
    const int tid_ = ltid();
    const int tid = tid_, wid = __builtin_amdgcn_readfirstlane(tid >> 6), lane = tid & 63, wr = wid >> 2, wc = wid & 3, fr = lane & 15, fq = lane >> 4;
    constexpr int nt = YW / BK;
    unsigned voffA[2], voffB[2];
#pragma unroll
    for (int i = 0; i < 2; ++i) { int R, C; stage_rc(tid * 16 + i * 8192, R, C); const int Rb = 64 * ((R >> 4) & 1) + 16 * (R >> 5) + (R & 15);
        voffA[i] = (unsigned)(R * YW + C) * 2u; voffB[i] = (unsigned)(Rb * YW + C) * 2u; }
    constexpr int kstep = BK * 2, hstepA = HALF * YW * 2, hstepB = 128 * YW * 2;
    const unsigned ldsw = (unsigned)wid * 1024u;
    const int aoff = lds_byte(wr * 64 + fr, fq * 8), boff = lds_byte(wc * 32 + fr, fq * 8);
    const __amdgpu_buffer_rsrc_t rsA = __builtin_amdgcn_make_buffer_rsrc((void*)(y + (size_t)pm * BM * YW), (short)0, BM * YW * 2, 0x00020000);
    const __amdgpu_buffer_rsrc_t rsB = __builtin_amdgcn_make_buffer_rsrc((void*)(wbr + (size_t)pn * BM * YW), (short)0, BM * YW * 2, 0x00020000);
#define MG_SA(b, h) (((b) * 2 + (h)) * HTB)
#define MG_SB(b, h) ((4 + (b) * 2 + (h)) * HTB)
#define MG_STAGE(bufoff, rs, soff, voff) do { _Pragma("unroll") for (int _i = 0; _i < 2; ++_i) \
        __builtin_amdgcn_raw_ptr_buffer_load_lds(rs, (PG8_LAS void*)(lds + (bufoff) + ldsw + _i * 8192), 16, (int)(voff)[_i], (int)(soff), 0, 0); } while (0)
#define MG_LDA(dst, b, h) do { _Pragma("unroll") for (int m = 0; m < 4; ++m) _Pragma("unroll") for (int k = 0; k < 2; ++k) dst[m][k] = *(const PG8_LAS bf16x8*)(lds + MG_SA(b, h) + aoff + m * 2048 + k * 1024); } while (0)
#define MG_LDB(dst, b, h) do { _Pragma("unroll") for (int n = 0; n < 2; ++n) _Pragma("unroll") for (int k = 0; k < 2; ++k) dst[n][k] = *(const PG8_LAS bf16x8*)(lds + MG_SB(b, h) + boff + n * 2048 + k * 1024); } while (0)
#define MG_MMA(ai, bj, At, Bt) do { __builtin_amdgcn_s_setprio(1); \
        _Pragma("unroll") for (int m = 0; m < 4; ++m) _Pragma("unroll") for (int n = 0; n < 2; ++n) _Pragma("unroll") for (int k = 0; k < 2; ++k) \
            acc[ai][bj][m][n] = __builtin_amdgcn_mfma_f32_16x16x32_bf16(Bt[n][k], At[m][k], acc[ai][bj][m][n], 0, 0, 0); \
        __builtin_amdgcn_s_setprio(0); } while (0)
#define MG_WAIT_V(n) asm volatile("s_waitcnt vmcnt(" #n ")" ::: "memory")
#define MG_WAIT_L(n) asm volatile("s_waitcnt lgkmcnt(" #n ")" ::: "memory")
#define MG_BAR __builtin_amdgcn_s_barrier()
#define MG_SCHED __builtin_amdgcn_sched_barrier(0)
#define MG_LOADR(ai, R) do { const int ro_ = (int)(((ai) * 8 + wid) * 8192) + lo_; \
        _Pragma("unroll") for (int j = 0; j < 8; ++j) R[j] = __builtin_bit_cast(u32x4, __builtin_amdgcn_raw_buffer_load_b128(rsS, ro_ + (j & 3) * 1024, (j >> 2) * 4096, 0)); } while (0)
#define MG_SCALE(ai, R) do { _Pragma("unroll") for (int bj = 0; bj < 2; ++bj) _Pragma("unroll") for (int n = 0; n < 2; ++n) _Pragma("unroll") for (int mh = 0; mh < 2; ++mh) { const u32x4 q = R[2 * (2 * bj + n) + mh]; \
        acc[ai][bj][2 * mh][n] *= (f32x4){bflo(q.x), bfhi(q.x), bflo(q.y), bfhi(q.y)}; acc[ai][bj][2 * mh + 1][n] *= (f32x4){bflo(q.z), bfhi(q.z), bflo(q.w), bfhi(q.w)}; MG_SCHED; } } while (0)
#define MG_BOUNDARY(plane) do { const __amdgpu_buffer_rsrc_t rsS = __builtin_amdgcn_make_buffer_rsrc((void*)(slab + (size_t)((plane) * 8192)), (short)0, 131072, 0x00020000); \
        const int tb_ = ltid(); const int lo_ = (tb_ & 63) * 16; u32x4 R0[8], R1[8];        MG_LOADR(0, R0); MG_LOADR(1, R1); MG_SCALE(0, R0); MG_SCALE(1, R1); MG_SCHED; } while (0)
#define MG_ITER(T, LAST) do { const int a1 = ((T) + 1) * kstep, a2 = (LAST) ? 0 : ((T) + 2) * kstep, a3 = a2 + kstep; \
        MG_LDB(B0, 0, 0); MG_LDB(B1, 0, 1); MG_SCHED; MG_LDA(At, 0, 0); MG_STAGE(MG_SA(1, 1), rsA, a1 + hstepA, voffA); \
        MG_WAIT_V(8); MG_WAIT_L(0); MG_BAR; MG_MMA(0, 0, At, B0); MG_MMA(0, 1, At, B1); MG_BAR; MG_SCHED; \
        MG_LDA(At, 0, 1); MG_STAGE(MG_SB(0, 0), rsB, a2, voffB); MG_STAGE(MG_SB(0, 1), rsB, a2 + hstepB, voffB); MG_STAGE(MG_SA(0, 0), rsA, a2, voffA); \
        MG_WAIT_V(8); MG_WAIT_L(0); MG_BAR; MG_MMA(1, 0, At, B0); MG_MMA(1, 1, At, B1); MG_BAR; MG_SCHED; \
        MG_LDB(B0, 1, 0); MG_LDB(B1, 1, 1); MG_SCHED; MG_LDA(At, 1, 0); MG_STAGE(MG_SA(0, 1), rsA, a2 + hstepA, voffA); \
        MG_WAIT_V(8); MG_WAIT_L(0); MG_BAR; MG_MMA(0, 0, At, B0); MG_MMA(0, 1, At, B1); MG_BAR; MG_SCHED; \
        MG_LDA(At, 1, 1); MG_STAGE(MG_SB(1, 0), rsB, a3, voffB); MG_STAGE(MG_SB(1, 1), rsB, a3 + hstepB, voffB); MG_STAGE(MG_SA(1, 0), rsA, a3, voffA); \
        MG_WAIT_V(8); MG_WAIT_L(0); MG_BAR; MG_MMA(1, 0, At, B0); MG_MMA(1, 1, At, B1); MG_BAR; MG_SCHED; } while (0)
    float z0_; asm volatile("v_mov_b32 %0, 0" : "=v"(z0_));
    f32x4 acc[2][2][4][2];
#pragma unroll
    for (int a = 0; a < 2; ++a)
#pragma unroll
        for (int b = 0; b < 2; ++b)
#pragma unroll
            for (int m = 0; m < 4; ++m)
#pragma unroll
                for (int n = 0; n < 2; ++n) acc[a][b][m][n] = (f32x4){z0_, z0_, z0_, z0_};
    bf16x8 At[4][2], B0[2][2], B1[2][2];
    MG_WAIT_V(0);
    MG_STAGE(MG_SB(0, 0), rsB, 0, voffB); MG_STAGE(MG_SB(0, 1), rsB, hstepB, voffB); MG_STAGE(MG_SA(0, 0), rsA, 0, voffA); MG_STAGE(MG_SA(0, 1), rsA, hstepA, voffA);
    if (wr == 1) MG_BAR;
    MG_WAIT_V(2); MG_BAR;
    MG_STAGE(MG_SB(1, 0), rsB, kstep, voffB); MG_STAGE(MG_SA(1, 0), rsA, kstep, voffA); MG_STAGE(MG_SB(1, 1), rsB, hstepB + kstep, voffB);
    MG_WAIT_V(6); MG_BAR;
#pragma unroll 1
    for (int t = 0; t < 12; t += 4) { MG_ITER(t, false); MG_ITER(t + 2, false); if constexpr (!NOB) MG_BOUNDARY(t >> 2); }
#pragma unroll 1
    for (int t = 12; t < nt; t += 2) MG_ITER(t, t == nt - 2);
    if (wr == 0) MG_BAR;
    {   typedef unsigned u32x2 __attribute__((ext_vector_type(2)));
        const __amdgpu_buffer_rsrc_t rsS = __builtin_amdgcn_make_buffer_rsrc((void*)(slab + (size_t)(3 * 8192)), (short)0, 131072, 0x00020000);
        const __amdgpu_buffer_rsrc_t rsO = __builtin_amdgcn_make_buffer_rsrc((void*)(xb + (size_t)pm * BM * D + pn * 256), (short)0, BM * D * 2, 0x00020000);
        const int t2_ = ltid(), w2_ = __builtin_amdgcn_readfirstlane(t2_ >> 6);
        const int lo_ = (t2_ & 63) * 16; const int ob = (((w2_ >> 2) * 64 + (t2_ & 15)) * D + (w2_ & 3) * 16 + ((t2_ >> 4) & 3) * 4) * 2;
        u32x4 R0[8], R1[8]; if constexpr (!NOB) { MG_LOADR(0, R0); MG_LOADR(1, R1); } MG_SCHED;
#define MG_OUT(ai, R) do { if constexpr (!NOB) MG_SCALE(ai, R); _Pragma("unroll") for (int m = 0; m < 4; ++m) _Pragma("unroll") for (int bj = 0; bj < 2; ++bj) _Pragma("unroll") for (int n = 0; n < 2; ++n) { \
            const f32x4 v = acc[ai][bj][m][n]; u32x2 w; w.x = cvt_pk_bf16(v[0], v[1]); w.y = cvt_pk_bf16(v[2], v[3]); \
            __builtin_amdgcn_raw_buffer_store_b64(w, rsO, ob, (((ai) * HALF + m * 16) * D + 64 * (2 * bj + n)) * 2, 0); MG_SCHED; } } while (0)
        MG_OUT(0, R0); MG_OUT(1, R1);
#undef MG_OUT
    }
    MG_WAIT_V(0);
    MG_BAR;
#undef MG_ITER
#undef MG_BOUNDARY
#undef MG_SA
#undef MG_SB
#undef MG_STAGE
#undef MG_LDA
#undef MG_LDB
#undef MG_MMA
#undef MG_WAIT_V
#undef MG_WAIT_L
#undef MG_BAR
#undef MG_SCHED
#undef MG_LOADR
#undef MG_SCALE
}

struct EpiRes {
    static constexpr bool AFTER_DRAIN = false;
    bf16_t* xa; float* out32; float* ssq; unsigned char* xa8;
    __device__ __forceinline__ void prefetch(RowPf&, const Unit&, int, int, int) const {}
    __device__ __forceinline__ void operator()(const f32x4 (&acc)[2][2][4][2], const Unit& u, int wr, int wc, int fr, int fq, const RowPf&) const {
        const int vo = (u.pm * BM + wr * 64 + fr) * D + u.pn * BM + wc * 64 + 8 * fq;
        u32x4 rb[2][4][2];
#pragma unroll
        for (int ai = 0; ai < 2; ++ai)
#pragma unroll
            for (int m = 0; m < 4; ++m)
#pragma unroll
                for (int bj = 0; bj < 2; ++bj) rb[ai][m][bj] = *(const u32x4*)(xa + (size_t)vo + (ai * HALF + m * 16) * D + 32 * bj);
        __builtin_amdgcn_sched_barrier(0);
#pragma unroll
        for (int ai = 0; ai < 2; ++ai) {
#pragma unroll
            for (int m = 0; m < 4; ++m) {
                const int so = (ai * HALF + m * 16) * D; float ss = 0.f;
#pragma unroll
                for (int bj = 0; bj < 2; ++bj) {
                    const u32x4 w = rb[ai][m][bj]; f32x4 a = (f32x4){bflo(w.x), bfhi(w.x), bflo(w.y), bfhi(w.y)}, b = (f32x4){bflo(w.z), bfhi(w.z), bflo(w.w), bfhi(w.w)};
                    a = a + acc[ai][bj][m][0]; b = b + acc[ai][bj][m][1];
                    if (out32) { __builtin_nontemporal_store(a, (f32x4*)(out32 + (size_t)vo + so + 32 * bj)); __builtin_nontemporal_store(b, (f32x4*)(out32 + (size_t)vo + so + 32 * bj + 4)); }
                    else *(u32x4*)(xa + (size_t)vo + so + 32 * bj) = pack8(a, b);
                    if (xa8) { typedef unsigned u32x2 __attribute__((ext_vector_type(2))); u32x2 w8; w8.x = pk4_f8(a[0], a[1], a[2], a[3]); w8.y = pk4_f8(b[0], b[1], b[2], b[3]);
                        *(u32x2*)(xa8 + (size_t)vo + so + 32 * bj) = w8; }
                    ss += ((a[0] * a[0] + a[1] * a[1]) + (a[2] * a[2] + a[3] * a[3])) + ((b[0] * b[0] + b[1] * b[1]) + (b[2] * b[2] + b[3] * b[3]));
                }
                if (ssq) { ss = sum_fq(ss); if (fq == 0) ((PG8_LAS float*)((PG8_LAS unsigned char*)lds_g_ + RED_OFF))[(ai * HALF + wr * 64 + m * 16 + fr) * 4 + wc] = ss; }
            }
        }
        if (ssq) {
            asm volatile("s_waitcnt lgkmcnt(0)" ::: "memory"); __builtin_amdgcn_s_barrier(); asm volatile("" ::: "memory");
            const int t = (wr * 4 + wc) * 64 + fq * 16 + fr;
            if (t < BM) { const f32x4 p = *(const PG8_LAS f32x4*)((PG8_LAS unsigned char*)lds_g_ + RED_OFF + t * 16); ssq[(size_t)(u.pm * BM + t) * 4 + u.pn] = (p.x + p.y) + (p.z + p.w); }
        }
    }
};
struct EpiFFN {
    static constexpr bool AFTER_DRAIN = false;
    bf16_t* act; const float* ssq;
    __device__ __forceinline__ void prefetch(RowPf& pf, const Unit& u, int wr, int fr, int tid) const { pf_rows(pf, ssq, u, wr, fr, tid); }
    __device__ __forceinline__ void operator()(const f32x4 (&acc)[2][2][4][2], const Unit& u, int wr, int wc, int fr, int fq, const RowPf& pf) const {
        pf_publish(pf, (wr * 4 + wc) * 64 + fq * 16 + fr);
#pragma unroll
        for (int ai = 0; ai < 2; ++ai)
#pragma unroll
            for (int m = 0; m < 4; ++m) {
                const int row = u.pm * BM + ai * HALF + wr * 64 + m * 16 + fr; const float r = pf_rstd(ai, wr, m, fr);
                f32x4 o[2];
#pragma unroll
                for (int n = 0; n < 2; ++n) { const f32x4 gt = acc[ai][0][m][n] * r, up = acc[ai][1][m][n] * r;
#pragma unroll
                    for (int e = 0; e < 4; ++e) o[n][e] = gt[e] * sigmoidf_(gt[e]) * up[e]; }
                *(u32x4*)(act + (size_t)row * DFF + u.pn * 128 + wc * 32 + 8 * fq) = pack8(o[0], o[1]);
            }
    }
};

template <class Epi, class Sched, bool ALIGN_EPI = false, bool SP2 = false, int BMODE = 0, bool F8 = false>
__device__ __forceinline__ void gemm_phase(PG8_LAS unsigned char* lds, const Gemm g, const Sched& S, const Epi& E) {
    const int tid_ = ltid();
    const int tid = tid_, wid = __builtin_amdgcn_readfirstlane(tid >> 6), lane = tid & 63, wr = wid >> 2, wc = wid & 3, fr = lane & 15, fq = lane >> 4;
    const int K = g.K, nt = K / BK;
    unsigned voffA[2], voffB[2];
#pragma unroll
    for (int i = 0; i < 2; ++i) { int R, C; stage_rc(tid * 16 + i * 8192, R, C); const int Rb = BMODE == 0 ? 64 * (R >> 5) + perm32(R & 31)
                                         : 1024 * ((R >> 4) & 1) + 16 * (R >> 5) + (R & 15);
        voffA[i] = (unsigned)(R * g.lda + C) * 2u; voffB[i] = (unsigned)(Rb * g.ldb + C) * 2u; }
    const size_t kstep = (size_t)(BK * 2);
    const size_t hstepA = (size_t)HALF * g.lda * 2, hstepB = (size_t)(BMODE == 0 ? 32 : 2048) * g.ldb * 2;
    const size_t tstepA = (size_t)BM * g.lda * 2, tstepB = (size_t)(BMODE == 0 ? BM : 64) * g.ldb * 2;
    const unsigned ldsw = (unsigned)wid * 1024u;
    const int aoff = lds_byte(wr * 64 + fr, fq * 8), boff = lds_byte(wc * 32 + fr, fq * 8);
#define PG8_SA(b, h) (((b) * 2 + (h)) * HTB)
#define PG8_SB(b, h) ((4 + (b) * 2 + (h)) * HTB)
#define PG8_STAGE(bufoff, gbase, voff) do { _Pragma("unroll") for (int _i = 0; _i < 2; ++_i) { \
        if constexpr (F8) { unsigned keep_; const char* sb_ = (const char*)(gbase); const unsigned ld_ = (unsigned)(size_t)(lds + (bufoff) + ldsw + _i * 8192); \
            asm volatile("s_mov_b32 %0, m0\n\ts_mov_b32 m0, %3\n\ts_nop 0\n\tglobal_load_lds_dwordx4 %1, %2\n\ts_mov_b32 m0, %0" : "=&s"(keep_) : "v"((voff)[_i]), "s"(sb_), "s"(ld_) : "memory"); } \
        else __builtin_amdgcn_global_load_lds((const unsigned*)((const char*)(gbase) + (voff)[_i]), (PG8_LAS unsigned*)(lds + (bufoff) + ldsw + _i * 8192), 16, 0, 0); } } while (0)
#define PG8_LDA(dst, b, h) do { if constexpr (F8) { _Pragma("unroll") for (int m = 0; m < 4; ++m) { const v4i32_ lo_ = *(const PG8_LAS v4i32_*)(lds + PG8_SA(b, h) + aoff + m * 2048), hi_ = *(const PG8_LAS v4i32_*)(lds + PG8_SA(b, h) + aoff + m * 2048 + 1024); dst##8[m] = __builtin_shufflevector(lo_, hi_, 0, 1, 2, 3, 4, 5, 6, 7); } } \
        else { _Pragma("unroll") for (int m = 0; m < 4; ++m) _Pragma("unroll") for (int k = 0; k < 2; ++k) dst[m][k] = *(const PG8_LAS bf16x8*)(lds + PG8_SA(b, h) + aoff + m * 2048 + k * 1024); } } while (0)
#define PG8_LDB(dst, b, h) do { if constexpr (F8) { _Pragma("unroll") for (int n = 0; n < 2; ++n) { const v4i32_ lo_ = *(const PG8_LAS v4i32_*)(lds + PG8_SB(b, h) + boff + n * 2048), hi_ = *(const PG8_LAS v4i32_*)(lds + PG8_SB(b, h) + boff + n * 2048 + 1024); dst##8[n] = __builtin_shufflevector(lo_, hi_, 0, 1, 2, 3, 4, 5, 6, 7); } } \
        else { _Pragma("unroll") for (int n = 0; n < 2; ++n) _Pragma("unroll") for (int k = 0; k < 2; ++k) dst[n][k] = *(const PG8_LAS bf16x8*)(lds + PG8_SB(b, h) + boff + n * 2048 + k * 1024); } } while (0)
#define PG8_MMA(ai, bj, At, Bt) do { __builtin_amdgcn_s_setprio(1); \
        if constexpr (F8) { _Pragma("unroll") for (int m = 0; m < 4; ++m) _Pragma("unroll") for (int n = 0; n < 2; ++n) \
            acc[ai][bj][m][n] = __builtin_amdgcn_mfma_scale_f32_16x16x128_f8f6f4(Bt##8[n], At##8[m], acc[ai][bj][m][n], 0, 0, 0, 0x7f7f7f7f, 0, 0x7f7f7f7f); } \
        else { _Pragma("unroll") for (int m = 0; m < 4; ++m) _Pragma("unroll") for (int n = 0; n < 2; ++n) _Pragma("unroll") for (int k = 0; k < 2; ++k) \
            acc[ai][bj][m][n] = __builtin_amdgcn_mfma_f32_16x16x32_bf16(Bt[n][k], At[m][k], acc[ai][bj][m][n], 0, 0, 0); } \
        __builtin_amdgcn_s_setprio(0); } while (0)
#define PG8_WAIT_V(n) asm volatile("s_waitcnt vmcnt(" #n ")" ::: "memory")
#define PG8_WAIT_L(n) asm volatile("s_waitcnt lgkmcnt(" #n ")" ::: "memory")
#define PG8_BAR __builtin_amdgcn_s_barrier()
#define PG8_SCHED __builtin_amdgcn_sched_barrier(0)
    Unit cur, nxt; int ui = 0; RowPf pf;
    if (!S.next(0, cur)) return;
    float z0_; asm volatile("v_mov_b32 %0, 0" : "=v"(z0_));
    f32x4 acc[2][2][4][2];
#pragma unroll
    for (int a = 0; a < 2; ++a)
#pragma unroll
        for (int b = 0; b < 2; ++b)
#pragma unroll
            for (int m = 0; m < 4; ++m)
#pragma unroll
                for (int n = 0; n < 2; ++n) acc[a][b][m][n] = (f32x4){z0_, z0_, z0_, z0_};
    bf16x8 At[4][2], B0[2][2], B1[2][2]; v8i32_ At8[4], B08[2], B18[2];
    const char* cA = (const char*)g.A + (size_t)cur.pm * tstepA; const char* cB = (const char*)g.Bt + (size_t)cur.pn * tstepB;
    S.a_ready(cur);
    if constexpr (SP2) {
        PG8_STAGE(PG8_SB(0, 0), cB, voffB); PG8_STAGE(PG8_SB(0, 1), cB + hstepB, voffB); PG8_STAGE(PG8_SA(0, 0), cA, voffA); PG8_STAGE(PG8_SA(0, 1), cA + hstepA, voffA);
        if (wr == 1) PG8_BAR;
        PG8_WAIT_V(2); PG8_BAR;
        PG8_STAGE(PG8_SB(1, 0), cB + kstep, voffB); PG8_STAGE(PG8_SA(1, 0), cA + kstep, voffA); PG8_STAGE(PG8_SB(1, 1), cB + hstepB + kstep, voffB);
        PG8_WAIT_V(6); PG8_BAR;
    } else {
        PG8_STAGE(PG8_SB(0, 0), cB, voffB); PG8_STAGE(PG8_SA(0, 0), cA, voffA); PG8_STAGE(PG8_SB(0, 1), cB + hstepB, voffB); PG8_STAGE(PG8_SA(0, 1), cA + hstepA, voffA);
        if (wr == 1) PG8_BAR;
        PG8_WAIT_V(4); PG8_BAR;
        PG8_STAGE(PG8_SB(1, 0), cB + kstep, voffB); PG8_STAGE(PG8_SA(1, 0), cA + kstep, voffA); PG8_STAGE(PG8_SB(1, 1), cB + hstepB + kstep, voffB);
        PG8_WAIT_V(6); PG8_BAR;
    }
    for (;;) {
        const bool has_next = S.next(ui + 1, nxt);
        const char* nA = has_next ? (const char*)g.A + (size_t)nxt.pm * tstepA : cA; const char* nB = has_next ? (const char*)g.Bt + (size_t)nxt.pn * tstepB : cB;
#pragma unroll 1
        for (int t = 0; t < nt; t += 2) {
            const bool last = (t == nt - 2);
            const char* a1 = cA + (size_t)(t + 1) * kstep;
            const char* a2 = last ? nA : cA + (size_t)(t + 2) * kstep; const char* b2 = last ? nB : cB + (size_t)(t + 2) * kstep;
            const char* a3 = a2 + kstep; const char* b3 = b2 + kstep;
            if (last && has_next) S.a_ready(nxt);
            if (last) E.prefetch(pf, cur, wr, fr, tid);
            if constexpr (SP2) {
            PG8_LDB(B0, 0, 0); PG8_LDB(B1, 0, 1); PG8_SCHED; PG8_LDA(At, 0, 0); PG8_STAGE(PG8_SA(1, 1), a1 + hstepA, voffA);
            PG8_WAIT_V(8); PG8_WAIT_L(0); PG8_BAR; PG8_MMA(0, 0, At, B0); PG8_MMA(0, 1, At, B1); PG8_BAR; PG8_SCHED;
            PG8_LDA(At, 0, 1); PG8_STAGE(PG8_SB(0, 0), b2, voffB); PG8_STAGE(PG8_SB(0, 1), b2 + hstepB, voffB); PG8_STAGE(PG8_SA(0, 0), a2, voffA);
            PG8_WAIT_V(8); PG8_WAIT_L(0); PG8_BAR; PG8_MMA(1, 0, At, B0); PG8_MMA(1, 1, At, B1); PG8_BAR; PG8_SCHED;
            PG8_LDB(B0, 1, 0); PG8_LDB(B1, 1, 1); PG8_SCHED; PG8_LDA(At, 1, 0); PG8_STAGE(PG8_SA(0, 1), a2 + hstepA, voffA);
            PG8_WAIT_V(8); PG8_WAIT_L(0); PG8_BAR; PG8_MMA(0, 0, At, B0); PG8_MMA(0, 1, At, B1); PG8_BAR; PG8_SCHED;
            PG8_LDA(At, 1, 1); PG8_STAGE(PG8_SB(1, 0), b3, voffB); PG8_STAGE(PG8_SB(1, 1), b3 + hstepB, voffB); PG8_STAGE(PG8_SA(1, 0), a3, voffA);
            PG8_WAIT_V(8); PG8_WAIT_L(0); PG8_BAR; PG8_MMA(1, 0, At, B0); PG8_MMA(1, 1, At, B1); PG8_BAR; PG8_SCHED;
            } else {
            PG8_LDB(B0, 0, 0); PG8_SCHED; PG8_LDA(At, 0, 0); PG8_STAGE(PG8_SA(1, 1), a1 + hstepA, voffA);
            PG8_WAIT_L(8); PG8_BAR; PG8_WAIT_L(0); PG8_MMA(0, 0, At, B0); PG8_BAR; PG8_SCHED;
            PG8_LDB(B1, 0, 1); PG8_STAGE(PG8_SB(0, 0), b2, voffB);
            PG8_BAR; PG8_WAIT_L(0); PG8_MMA(0, 1, At, B1); PG8_BAR;
            PG8_LDA(At, 0, 1); PG8_STAGE(PG8_SA(0, 0), a2, voffA);
            PG8_BAR; PG8_WAIT_L(0); PG8_MMA(1, 0, At, B0); PG8_BAR; PG8_SCHED;
            PG8_STAGE(PG8_SB(0, 1), b2 + hstepB, voffB);
            PG8_WAIT_V(6); PG8_BAR; PG8_MMA(1, 1, At, B1); PG8_BAR;
            PG8_LDB(B0, 1, 0); PG8_SCHED; PG8_LDA(At, 1, 0); PG8_STAGE(PG8_SA(0, 1), a2 + hstepA, voffA);
            PG8_WAIT_L(8); PG8_BAR; PG8_WAIT_L(0); PG8_MMA(0, 0, At, B0); PG8_BAR; PG8_SCHED;
            PG8_LDB(B1, 1, 1); PG8_STAGE(PG8_SB(1, 0), b3, voffB);
            PG8_BAR; PG8_WAIT_L(0); PG8_MMA(0, 1, At, B1); PG8_BAR;
            PG8_LDA(At, 1, 1); PG8_STAGE(PG8_SA(1, 0), a3, voffA);
            PG8_BAR; PG8_WAIT_L(0); PG8_MMA(1, 0, At, B0); PG8_BAR; PG8_SCHED;
            PG8_STAGE(PG8_SB(1, 1), b3 + hstepB, voffB);
            PG8_WAIT_V(6); PG8_BAR; PG8_MMA(1, 1, At, B1); PG8_BAR;
            }
        }
        if constexpr (ALIGN_EPI) { if (wr == 0) PG8_BAR; }
        if constexpr (!Epi::AFTER_DRAIN) { E(acc, cur, wr, wc, fr, fq, pf); S.done(cur); }
        if (!has_next) break;
        float z1_; asm volatile("v_mov_b32 %0, 0" : "=v"(z1_));
#pragma unroll
        for (int a = 0; a < 2; ++a)
#pragma unroll
            for (int b = 0; b < 2; ++b)
#pragma unroll
                for (int m = 0; m < 4; ++m)
#pragma unroll
                    for (int n = 0; n < 2; ++n) acc[a][b][m][n] = (f32x4){z1_, z1_, z1_, z1_};
        cur = nxt; cA = nA; cB = nB; ++ui;
        if constexpr (ALIGN_EPI) { if (wr == 1) PG8_BAR; }
    }
    PG8_WAIT_V(0);
    if constexpr (!ALIGN_EPI) { if (wr == 0) PG8_BAR; }
    PG8_BAR;
    if constexpr (Epi::AFTER_DRAIN) { E.fused(acc, cur, wr, wc, fr, fq, lds, wid, lane); S.done(cur); }
#undef PG8_SA
#undef PG8_SB
#undef PG8_STAGE
#undef PG8_LDA
#undef PG8_LDB
#undef PG8_MMA
#undef PG8_WAIT_V
#undef PG8_WAIT_L
#undef PG8_BAR
#undef PG8_SCHED
}
}

#define XB_TMO      128
#define XB_XCNT(j)  (256  + 64 * (j))
#define XB_XSUB(j)  (1280 + 64 * (j))
#define XB_XGEN(j)  (2304 + 64 * (j))
#define XB_TOP      3328
#define XB_TOPGEN   3392
#define XCD_BAR_WORDS 3456
#define XB_SPIN_CAP (1u << 23)

__device__ __forceinline__ unsigned xb_ld(unsigned* p)              { return __hip_atomic_load(p, __ATOMIC_RELAXED, __HIP_MEMORY_SCOPE_AGENT); }
__device__ __forceinline__ unsigned xb_add(unsigned* p, unsigned v) { return __hip_atomic_fetch_add(p, v, __ATOMIC_RELAXED, __HIP_MEMORY_SCOPE_AGENT); }
__device__ __forceinline__ unsigned xb_xcc_id() { return (unsigned)__builtin_amdgcn_s_getreg((3 << 11) | 20) & 0xFu; }
#define XB_SPIN(cond, bar) do { unsigned _sp = 0; while (cond) { __builtin_amdgcn_s_sleep(1); \
    if ((++_sp & 255u) == 0u) { if (xb_ld(&(bar)[XB_TMO])) break; if (_sp > XB_SPIN_CAP) { atomicAdd(&(bar)[XB_TMO], 1u); break; } } } } while (0)

struct XcdBarrier {
    unsigned* bar; unsigned x;
    volatile LAS unsigned* st;
};

__device__ __forceinline__ XcdBarrier xcd_barrier_post(unsigned* bar, volatile LAS unsigned* st) {
    XcdBarrier b; b.bar = bar; b.x = xb_xcc_id(); b.st = st;
    if (ltid() == 0) (void)xb_add(&bar[XB_XCNT(b.x)], 1u);
    return b;
}
__device__ __forceinline__ void xcd_barrier_complete(unsigned* bar, unsigned x, unsigned& nloc, unsigned& nx) {
    const unsigned G = gridDim.x * gridDim.y * gridDim.z;
    unsigned sum, cnt, mine, sp = 0u;
    for (;;) {
        sum = 0u; cnt = 0u; mine = 0u;
#pragma unroll
        for (unsigned j = 0; j < 16; ++j) { const unsigned c = xb_ld(&bar[XB_XCNT(j)]); sum += c; cnt += (c > 0u) ? 1u : 0u; mine = (j == x) ? c : mine; }
        if (sum == G) break;
        __builtin_amdgcn_s_sleep(1);
        if ((++sp & 255u) == 0u) { if (xb_ld(&bar[XB_TMO])) break; if (sp > XB_SPIN_CAP) { atomicAdd(&bar[XB_TMO], 1u); break; } }
    }
    nloc = mine > 0u ? mine : 1u; nx = cnt > 0u ? cnt : 1u;
}

__device__ __forceinline__ void xcd_barrier(const XcdBarrier& b) {
    asm volatile("s_waitcnt vmcnt(0)" ::: "memory");
    __syncthreads();
    if (ltid() == 0) {
        unsigned* bar = b.bar;
        __builtin_amdgcn_s_waitcnt(0);
        unsigned nloc = b.st[0], nx = b.st[1];
        if (nloc == 0u) { xcd_barrier_complete(bar, b.x, nloc, nx); b.st[0] = nloc; b.st[1] = nx; }
        const unsigned old = xb_add(&bar[XB_XSUB(b.x)], 1u);
        const unsigned gen = old / nloc;
        if (old + 1u == (gen + 1u) * nloc) {
            __builtin_amdgcn_fence(__ATOMIC_RELEASE, "agent");
            asm volatile("s_waitcnt vmcnt(0)" ::: "memory");
            const unsigned og = xb_add(&bar[XB_TOP], 1u);
            const unsigned tg = og / nx;
            if (og + 1u == (tg + 1u) * nx) xb_add(&bar[XB_TOPGEN], 1u);
            else XB_SPIN(xb_ld(&bar[XB_TOPGEN]) == tg, bar);
            __builtin_amdgcn_fence(__ATOMIC_ACQUIRE, "agent");
            xb_add(&bar[XB_XGEN(b.x)], 1u);
            asm volatile("s_waitcnt vmcnt(0)" ::: "memory");
        } else {
            XB_SPIN(xb_ld(&bar[XB_XGEN(b.x)]) == gen, bar);
            __builtin_amdgcn_fence(__ATOMIC_ACQUIRE, "agent");
            asm volatile("s_waitcnt vmcnt(0)" ::: "memory");
        }
    }
    __syncthreads();
}

namespace fox_body {
using bf16=__hip_bfloat16;
using bf16x8=__attribute__((ext_vector_type(8)))short;
using s16x4=__attribute__((ext_vector_type(4)))short;
using f32x16=__attribute__((ext_vector_type(16)))float;
using u32x4=__attribute__((ext_vector_type(4)))unsigned;
constexpr int SEQ=2048,D=64,DM=3328,OM=1280;
constexpr int NW=8,QBLK=32,QB=QBLK*NW,KVBLK=64,NQB=SEQ/QB;
constexpr int ATTN_PITCH=DM, ATTN_UNIT_ROWS=QB;
__device__ __forceinline__ int crow(int r,int hi){return (r&3)+8*(r>>2)+4*hi;}
#define SBAR() __builtin_amdgcn_sched_barrier(0)
__device__ __forceinline__ void cmask(f32x16&p0,f32x16&p1,int jb,int qrel,int hi){
  const float NEG=-INFINITY; int kb=64*jb+4*hi;
  #pragma unroll
  for(int r=0;r<16;++r){int kv=kb+(r&3)+8*(r>>2); if(kv>qrel)p0[r]=NEG; if(kv+32>qrel)p1[r]=NEG;}
}

constexpr int NSLOT=3, SLOTB=8192;
constexpr int LDS_K=0, LDS_V=NSLOT*SLOTB, LDS_WS=2*NSLOT*SLOTB, LDS_OST=LDS_WS+NW*64*4, LDS_BYTES=LDS_OST+NW*4096, LDS_CPK=LDS_BYTES, LDS_TOTAL=LDS_CPK+SEQ*4;
constexpr float C2=0.125f*1.4426950408889634f;
__device__ __forceinline__ void glds16(const void*gsrc,unsigned lds_dst){unsigned keep;
  asm volatile("s_mov_b32 %0, m0\n\ts_mov_b32 m0, %2\n\ts_nop 0\n\tglobal_load_lds_dwordx4 %1, off\n\ts_mov_b32 m0, %0":"=&s"(keep):"v"(gsrc),"s"(lds_dst):"memory");}
__device__ __forceinline__ float max3f(float a,float b,float c){float r;asm("v_max3_f32 %0, %1, %2, %3":"=v"(r):"v"(a),"v"(b),"v"(c));return r;}
__device__ __forceinline__ float max2f(float a,float b){float r;asm("v_max_f32_e32 %0, %1, %2":"=v"(r):"v"(a),"v"(b));return r;}
__device__ __forceinline__ float fadd_s(float a,float b){float r;asm("v_add_f32_e32 %0, %1, %2":"=v"(r):"v"(a),"v"(b));return r;}
__device__ __forceinline__ float fsub_s(float a,float b){float r;asm("v_sub_f32_e32 %0, %1, %2":"=v"(r):"v"(a),"v"(b));return r;}
typedef float f32x2_t __attribute__((ext_vector_type(2))); typedef __bf16 bf16x2_t __attribute__((ext_vector_type(2)));
__device__ __forceinline__ unsigned cvtpk_s(float lo,float hi){f32x2_t v={lo,hi};bf16x2_t b=__builtin_convertvector(v,bf16x2_t);return __builtin_bit_cast(unsigned,b);}
#define WAIT_BAR(N) asm volatile("s_waitcnt vmcnt(" #N ") lgkmcnt(0)\n\ts_barrier":::"memory")

__device__ __forceinline__ void qkt(f32x16&p0,f32x16&p1,const char*Kslot,const bf16x8*qr,int r32,int hi,bf16x8 kx0,bf16x8 kx1,bf16x8 qx){
  const char*kb=Kslot+hi*1024+r32*16;
  #pragma unroll
  for(int d0=0;d0<4;++d0){
    const bf16x8 b0=*reinterpret_cast<const bf16x8*>(kb+d0*2048);
    const bf16x8 b1=*reinterpret_cast<const bf16x8*>(kb+d0*2048+512);
    if(d0==0){p0=__builtin_amdgcn_mfma_f32_32x32x16_bf16(b0,qr[0],f32x16{},0,0,0);p1=__builtin_amdgcn_mfma_f32_32x32x16_bf16(b1,qr[0],f32x16{},0,0,0);}
    else{p0=__builtin_amdgcn_mfma_f32_32x32x16_bf16(b0,qr[d0],p0,0,0,0);p1=__builtin_amdgcn_mfma_f32_32x32x16_bf16(b1,qr[d0],p1,0,0,0);}}
  p0=__builtin_amdgcn_mfma_f32_32x32x16_bf16(kx0,qx,p0,0,0,0);p1=__builtin_amdgcn_mfma_f32_32x32x16_bf16(kx1,qx,p1,0,0,0);
}
typedef __attribute__((address_space(3))) const char* lds_cptr;
typedef short v4i16_t __attribute__((ext_vector_type(4)));
__device__ __forceinline__ void kload8(bf16x8*kf,lds_cptr kp){
  kf[0]=*(const __attribute__((address_space(3))) bf16x8*)(kp);      kf[1]=*(const __attribute__((address_space(3))) bf16x8*)(kp+512);
  kf[2]=*(const __attribute__((address_space(3))) bf16x8*)(kp+2048); kf[3]=*(const __attribute__((address_space(3))) bf16x8*)(kp+2560);
  kf[4]=*(const __attribute__((address_space(3))) bf16x8*)(kp+4096); kf[5]=*(const __attribute__((address_space(3))) bf16x8*)(kp+4608);
  kf[6]=*(const __attribute__((address_space(3))) bf16x8*)(kp+6144); kf[7]=*(const __attribute__((address_space(3))) bf16x8*)(kp+6656);
}
__device__ __forceinline__ void kload2(bf16x8*kf,lds_cptr kp,int j){ kf[2*j]=*(const __attribute__((address_space(3))) bf16x8*)(kp+j*2048); kf[2*j+1]=*(const __attribute__((address_space(3))) bf16x8*)(kp+j*2048+512); }
__device__ __forceinline__ s16x4 vtr(lds_cptr p){ return __builtin_bit_cast(s16x4,__builtin_amdgcn_ds_read_tr16_b64_v4i16((__attribute__((address_space(3))) v4i16_t*)p)); }
__device__ __forceinline__ float rowmax(const f32x16&p0,const f32x16&p1){
  float a=max3f(p0[0],p0[1],p1[0]),b=max3f(p0[2],p0[3],p1[1]);a=max3f(a,p1[2],p1[3]);
  #pragma unroll
  for(int r=4;r<16;r+=4){a=max3f(a,p0[r],p0[r+1]);b=max3f(b,p0[r+2],p0[r+3]);a=max3f(a,p1[r],p1[r+1]);b=max3f(b,p1[r+2],p1[r+3]);}
  const float m=max2f(a,b);
  auto rr=__builtin_amdgcn_permlane32_swap(__float_as_uint(m),__float_as_uint(m),false,false);
  return max2f(__uint_as_float(rr[0]),__uint_as_float(rr[1]));
}
__device__ __forceinline__ void pv(f32x16*o,int vb,bf16x8 pa0,bf16x8 pa1,bf16x8 pa2,bf16x8 pa3){
  #pragma unroll
  for(int d0=0;d0<2;++d0){s16x4 lo[4],hi[4];
    #pragma unroll
    for(int ks=0;ks<4;++ks){
      asm volatile("ds_read_b64_tr_b16 %0,%1 offset:%c2":"=&v"(lo[ks]):"v"(vb),"i"(d0*4096+ks*1024):"memory");
      asm volatile("ds_read_b64_tr_b16 %0,%1 offset:%c2":"=&v"(hi[ks]):"v"(vb),"i"(d0*4096+ks*1024+512):"memory");}
    asm volatile("s_waitcnt lgkmcnt(0)":::"memory");SBAR();
    #define PK(k) (bf16x8){lo[k][0],lo[k][1],lo[k][2],lo[k][3],hi[k][0],hi[k][1],hi[k][2],hi[k][3]}
    o[d0]=__builtin_amdgcn_mfma_f32_32x32x16_bf16(pa0,PK(0),o[d0],0,0,0);
    o[d0]=__builtin_amdgcn_mfma_f32_32x32x16_bf16(pa1,PK(1),o[d0],0,0,0);
    o[d0]=__builtin_amdgcn_mfma_f32_32x32x16_bf16(pa2,PK(2),o[d0],0,0,0);
    o[d0]=__builtin_amdgcn_mfma_f32_32x32x16_bf16(pa3,PK(3),o[d0],0,0,0);
    #undef PK
  }
}

#ifndef ATTN_STORE16
#define ATTN_STORE16(p,v) (*(u32x4*)(p)=(v))
#endif
template<int THRL> __device__ __forceinline__ void attn_unit(int b,int h,int qb,const bf16*Q,const bf16*__restrict__ K,const bf16*__restrict__ V,bf16*O,char*shm){
  const int tid_=ltid(); const int tid=tid_,lane=tid&63,r32=lane&31,hi=lane>>5;     const int wid=__builtin_amdgcn_readfirstlane(tid>>6);
  const long rowbase=(long)b*SEQ; const int q0=qb*QB;
  const bf16*Qw=Q+(rowbase+q0+wid*QBLK)*DM+h*D;
  const __attribute__((address_space(3))) unsigned* cpk3=(const __attribute__((address_space(3))) unsigned*)((__attribute__((address_space(3))) const char*)shm+LDS_CPK);
  const bf16*Kh=K+rowbase*DM+h*D,*Vh=V+rowbase*DM+h*D;
  const unsigned lds0=(unsigned)(uintptr_t)shm;
  float*wsf=(float*)(shm+LDS_WS)+wid*64;
  const bf16*ksrc=Kh+(long)lane*DM+wid*8;
  const bf16*vsrc=Vh+(long)(16*(wid&3)+(lane>>2))*DM+(wid>>2)*32+(lane&3)*8;
  const unsigned kdst=lds0+LDS_K+wid*1024, vdst=lds0+LDS_V+wid*1024;
  #define DMA_K(t,slot) glds16(ksrc+(long)(t)*KVBLK*DM,(unsigned)__builtin_amdgcn_readfirstlane(kdst+(slot)))
  #define DMA_V(t,slot) glds16(vsrc+(long)(t)*KVBLK*DM,(unsigned)__builtin_amdgcn_readfirstlane(vdst+(slot)))
  const int vb0=(int)(lds0+LDS_V)+((lane>>4)&1)*32+(lane&3)*8+(4*hi+((lane&15)>>2))*64;
  const char*Kbase=shm+LDS_K; bf16x8 kf[8];
  const lds_cptr shm3=(lds_cptr)shm; const lds_cptr kp0=shm3+LDS_K+hi*1024+r32*16; const lds_cptr vp0=shm3+LDS_V+((lane>>4)&1)*32+(lane&3)*8+(4*hi+((lane&15)>>2))*64;
  const int NT=(q0+QB)/KVBLK;
  DMA_K(0,0);DMA_V(0,0);DMA_K(1,SLOTB);
  bf16x8 qr[4];
  #pragma unroll
  for(int d0=0;d0<4;++d0)qr[d0]=*reinterpret_cast<const bf16x8*>(&Qw[(long)r32*DM+d0*16+hi*8]);
  u32x4 qxw; { const unsigned cq_=cpk3[q0+wid*QBLK+r32]^0x80008000u; qxw=hi?(u32x4){0u,0u,0u,0u}:(u32x4){cq_,0x3f803f80u,0u,0u}; }
  #define QX __builtin_bit_cast(bf16x8,qxw)
  #define QXM() do{ const unsigned hb_=cvtpk_s(mhat,0.f)&0xffffu; const float hf_=__uint_as_float(hb_<<16); const unsigned pk_=cvtpk_s(hf_,mhat-hf_); qxw[2]=hi?0u:pk_; }while(0)
  #define KXF(kv) __builtin_bit_cast(bf16x8,(u32x4){0x3f803f80u,cpk3[(kv)],0xbf80bf80u,0u})
  float mhat=0.f,l_reg=0.f;f32x16 o[2];o[0]=f32x16{};o[1]=f32x16{};
  const int qrel=wid*QBLK+r32;
  #define CMASK(P0,P1,t) do{int jb_=(t)-(NT-4); if(jb_>=0)cmask(P0,P1,jb_,qrel,hi);}while(0)
  bool resc=false;
  #define START(P0,P1) do{ const float rm=__builtin_fmaxf(rowmax(P0,P1),-24.f); resc=false;   \
    { const float dl=rm; mhat=fadd_s(mhat,dl); \
      _Pragma("unroll") for(int r=0;r<16;++r){P0[r]=fsub_s(P0[r],dl);P1[r]=fsub_s(P1[r],dl);} \
      QXM(); } \
    _Pragma("unroll") for(int r=0;r<16;++r)P0[r]=__builtin_amdgcn_exp2f(P0[r]); }while(0)
  #define RESC() do{ if(resc){ asm volatile("s_waitcnt lgkmcnt(0)":::"memory"); \
      _Pragma("unroll") for(int d_=0;d_<2;++d_) _Pragma("unroll") for(int r=0;r<16;++r)o[d_][r]*=wsf[crow(r,hi)]; } }while(0)
  f32x16 pA0,pA1,pB0,pB1;
  int sl_prev=0,sl_cur=0,sl_next=SLOTB;
  #define ROT() do{sl_prev=sl_cur;sl_cur=sl_next;sl_next=(sl_next==(NSLOT-1)*SLOTB)?0:sl_next+SLOTB;}while(0)
  DMA_K(2,2*SLOTB);
  WAIT_BAR(3);
  qkt(pA0,pA1,Kbase,qr,r32,hi,KXF(r32),KXF(32+r32),QX);asm volatile("s_nop 15\n\ts_nop 7":"+v"(pA0),"+v"(pA1));CMASK(pA0,pA1,0);
  START(pA0,pA1);
  _Pragma("unroll") for(int r=0;r<16;++r)pA1[r]=__builtin_amdgcn_exp2f(pA1[r]);
  WAIT_BAR(0);
  DMA_K(3,0);DMA_V(1,SLOTB);
  ROT();
  kload8(kf,kp0+sl_cur);
  WAIT_BAR(2);
  s16x4 vlo[8],vhi[8]; u32x4 pw0,pw1,pw2,pw3;
  #define PKW(P,B) cvtpk_s(P[B],P[B+1])
  #define PAF(k) __builtin_bit_cast(bf16x8,pw##k)
  #define VFR(i) (bf16x8){vlo[i][0],vlo[i][1],vlo[i][2],vlo[i][3],vhi[i][0],vhi[i][1],vhi[i][2],vhi[i][3]}
  #define PIN(x) asm volatile("":"+v"(x))
  #define MX3(a,b,c) __builtin_fmaxf(__builtin_fmaxf((a),(b)),(c))
  #define GAPA(MF,A0,A1,A2,A3,W0,W1,PW) do{ MF; sacc+=A0; sacc+=A1; sacc+=A2; sacc+=A3; PIN(sacc); W0; W1; PIN(PW); SBAR(); }while(0)
  #define EX(v) __builtin_amdgcn_exp2f(v)
  #define GAPB(MF,X,B) do{ MF; X[B]=EX(X[B]); X[B+1]=EX(X[B+1]); X[B+2]=EX(X[B+2]); X[B+3]=EX(X[B+3]); PIN(X); SBAR(); }while(0)
  #define VRD(i) do{ vlo[i]=vtr(vp_+(((i)>>2)*4096+((i)&3)*1024)); vhi[i]=vtr(vp_+(((i)>>2)*4096+((i)&3)*1024+512)); }while(0)
  #define KRD(G,j) do{ if(G){ kload2(kf,kp0+sl_next,j); SBAR(); } }while(0)
  #define STEP(C0,C1,P0,P1,t,GK,GV,GL) do{ SBAR(); \
    const lds_cptr vp_=vp0+sl_prev; const bf16x8 kx0_=KXF((t)*64+r32), kx1_=KXF((t)*64+32+r32); \
    VRD(0); SBAR(); float sacc=(P0[0]+P0[1]); \
    GAPA(C0=__builtin_amdgcn_mfma_f32_32x32x16_bf16(kf[0],qr[0],f32x16{},0,0,0), P0[2],P0[3],P0[4],P0[5],     pw0[0]=PKW(P0,0), pw0[1]=PKW(P0,2), pw0); \
    VRD(4); SBAR(); GAPA(C1=__builtin_amdgcn_mfma_f32_32x32x16_bf16(kf[1],qr[0],f32x16{},0,0,0), P0[6],P0[7],P0[8],P0[9],     pw0[2]=PKW(P0,4), pw0[3]=PKW(P0,6), pw0); \
    VRD(1); SBAR(); GAPA(C0=__builtin_amdgcn_mfma_f32_32x32x16_bf16(kf[2],qr[1],C0,0,0,0),   P0[10],P0[11],P0[12],P0[13], pw1[0]=PKW(P0,8), pw1[1]=PKW(P0,10), pw1); \
    VRD(5); SBAR(); GAPA(C1=__builtin_amdgcn_mfma_f32_32x32x16_bf16(kf[3],qr[1],C1,0,0,0),   P0[14],P0[15],P1[0],P1[1],   pw1[2]=PKW(P0,12),pw1[3]=PKW(P0,14), pw1); \
    VRD(2); SBAR(); GAPA(C0=__builtin_amdgcn_mfma_f32_32x32x16_bf16(kf[4],qr[2],C0,0,0,0),   P1[2],P1[3],P1[4],P1[5],     pw2[0]=PKW(P1,0), pw2[1]=PKW(P1,2), pw2); \
    VRD(6); SBAR(); GAPA(C1=__builtin_amdgcn_mfma_f32_32x32x16_bf16(kf[5],qr[2],C1,0,0,0),   P1[6],P1[7],P1[8],P1[9],     pw2[2]=PKW(P1,4), pw2[3]=PKW(P1,6), pw2); \
    VRD(3); SBAR(); GAPA(C0=__builtin_amdgcn_mfma_f32_32x32x16_bf16(kf[6],qr[3],C0,0,0,0),   P1[10],P1[11],P1[12],P1[13], pw3[0]=PKW(P1,8), pw3[1]=PKW(P1,10), pw3); \
    VRD(7); SBAR(); GAPA(C1=__builtin_amdgcn_mfma_f32_32x32x16_bf16(kf[7],qr[3],C1,0,0,0),   P1[14],P1[15],0.f,0.f,       pw3[2]=PKW(P1,12),pw3[3]=PKW(P1,14), pw3); \
    C0=__builtin_amdgcn_mfma_f32_32x32x16_bf16(kx0_,QX,C0,0,0,0); C1=__builtin_amdgcn_mfma_f32_32x32x16_bf16(kx1_,QX,C1,0,0,0); \
    l_reg+=sacc; \
    if(GK){DMA_K((t)+3,sl_cur);} if(GV){DMA_V((t)+1,sl_next);} \
    CMASK(C0,C1,t); \
    { float a=MX3(C0[0],C0[1],C1[0]),b=MX3(C0[2],C0[3],C1[1]); a=MX3(a,C1[2],C1[3]); \
      _Pragma("unroll") for(int r=4;r<16;r+=4){a=MX3(a,C0[r],C0[r+1]);b=MX3(b,C0[r+2],C0[r+3]);a=MX3(a,C1[r],C1[r+1]);b=MX3(b,C1[r+2],C1[r+3]);} \
      float rm=__builtin_fmaxf(a,b); { auto rr=__builtin_amdgcn_permlane32_swap(__float_as_uint(rm),__float_as_uint(rm),false,false); rm=__builtin_fmaxf(__uint_as_float(rr[0]),__uint_as_float(rr[1])); } \
      resc=false; \
      if(__builtin_expect(__any(rm>(float)THRL),0)){ const float dl=__builtin_fmaxf(rm,0.f); mhat+=dl; \
        _Pragma("unroll") for(int r=0;r<16;++r){C0[r]-=dl;C1[r]-=dl;} \
        QXM(); \
        const float f=__builtin_amdgcn_exp2f(-dl); l_reg*=f; if(hi==0)wsf[r32]=f; resc=true; } } \
    SBAR(); \
    GAPB(o[0]=__builtin_amdgcn_mfma_f32_32x32x16_bf16(PAF(0),VFR(0),o[0],0,0,0), C0,0); \
    GAPB(o[1]=__builtin_amdgcn_mfma_f32_32x32x16_bf16(PAF(0),VFR(4),o[1],0,0,0), C0,4); \
    KRD(GL,0); GAPB(o[0]=__builtin_amdgcn_mfma_f32_32x32x16_bf16(PAF(1),VFR(1),o[0],0,0,0), C0,8); \
    KRD(GL,1); GAPB(o[1]=__builtin_amdgcn_mfma_f32_32x32x16_bf16(PAF(1),VFR(5),o[1],0,0,0), C0,12); \
    KRD(GL,2); GAPB(o[0]=__builtin_amdgcn_mfma_f32_32x32x16_bf16(PAF(2),VFR(2),o[0],0,0,0), C1,0); \
    KRD(GL,3); GAPB(o[1]=__builtin_amdgcn_mfma_f32_32x32x16_bf16(PAF(2),VFR(6),o[1],0,0,0), C1,4); \
    GAPB(o[0]=__builtin_amdgcn_mfma_f32_32x32x16_bf16(PAF(3),VFR(3),o[0],0,0,0), C1,8); \
    GAPB(o[1]=__builtin_amdgcn_mfma_f32_32x32x16_bf16(PAF(3),VFR(7),o[1],0,0,0), C1,12); \
    }while(0)
  int t=1;
  #undef CMASK
  #define CMASK(P0,P1,t) do{}while(0)
  for(;t+5<NT;t+=2){
    STEP(pB0,pB1,pA0,pA1,t,true,true,true);     WAIT_BAR(2); RESC(); ROT();
    STEP(pA0,pA1,pB0,pB1,t+1,true,true,true);   WAIT_BAR(2); RESC(); ROT();
  }
  #undef CMASK
  #define CMASK(P0,P1,t) do{int jb_=(t)-(NT-4); if(jb_>=0)cmask(P0,P1,jb_,qrel,hi);}while(0)
  #define ENDW(tt) do{ if((tt)+3<NT){WAIT_BAR(2);} else if((tt)+2<NT){WAIT_BAR(1);} else {WAIT_BAR(0);} }while(0)
  for(;t+1<NT;t+=2){
    STEP(pB0,pB1,pA0,pA1,t,(t+3<NT),(t+1<NT),(t+1<NT));       ENDW(t);   RESC(); ROT();
    STEP(pA0,pA1,pB0,pB1,t+1,(t+4<NT),(t+2<NT),(t+2<NT));     ENDW(t+1); RESC(); ROT();
  }
  STEP(pB0,pB1,pA0,pA1,NT-1,false,false,false); RESC();
  { float sacc=pB0[0]+pB0[1]; _Pragma("unroll") for(int r=2;r<16;++r)sacc+=pB0[r]; _Pragma("unroll") for(int r=0;r<16;++r)sacc+=pB1[r]; l_reg+=sacc;
    pw0=(u32x4){PKW(pB0,0),PKW(pB0,2),PKW(pB0,4),PKW(pB0,6)};pw1=(u32x4){PKW(pB0,8),PKW(pB0,10),PKW(pB0,12),PKW(pB0,14)};pw2=(u32x4){PKW(pB1,0),PKW(pB1,2),PKW(pB1,4),PKW(pB1,6)};pw3=(u32x4){PKW(pB1,8),PKW(pB1,10),PKW(pB1,12),PKW(pB1,14)};
    SBAR(); pv(o,vb0+sl_cur,PAF(0),PAF(1),PAF(2),PAF(3)); }
  #undef PKW
  #undef PAF
  #undef VFR
  #undef PIN
  #undef MX3
  #undef GAPA
  #undef GAPB
  #undef EX
  #undef VRD
  #undef KRD
  #undef KXF
  #undef QX
  #undef QXM
  #undef STEP
  #undef ENDW
  {auto rr=__builtin_amdgcn_permlane32_swap(__float_as_uint(l_reg),__float_as_uint(l_reg),false,false);l_reg=__uint_as_float(rr[0])+__uint_as_float(rr[1]);}
  if(hi==0)wsf[32+r32]=l_reg;asm volatile("s_waitcnt lgkmcnt(0)":::"memory");
  float rli[16];
  #pragma unroll
  for(int r=0;r<16;++r)rli[r]=__builtin_amdgcn_rcpf(wsf[32+crow(r,hi)]);
  bf16*Ow=O+(rowbase+q0+wid*QBLK)*OM+h*D;
  { bf16*stg=(bf16*)(shm+LDS_OST)+wid*2048;
    #pragma unroll
    for(int r=0;r<16;++r){const int orow=crow(r,hi);
      #pragma unroll
      for(int d0=0;d0<2;++d0)stg[orow*64+d0*32+r32]=__float2bfloat16(o[d0][r]*rli[r]);}
    asm volatile("s_waitcnt lgkmcnt(0)":::"memory");
    #pragma unroll
    for(int i=0;i<4;++i){const int row=i*8+(lane>>3),ch=lane&7; const u32x4 v=*(const u32x4*)(stg+row*64+ch*8); ATTN_STORE16(Ow+(long)row*OM+ch*8,v);} }
  asm volatile("s_waitcnt lgkmcnt(0)\n\ts_barrier":::"memory");
  #undef DMA_K
  #undef DMA_V
  #undef CMASK
  #undef START
  #undef RESC
  #undef ROT
}
#undef SBAR
#undef WAIT_BAR
}

__device__ __forceinline__ void fox_phase(char* shm, const bf16* PROJ, const float* SMALL, const float* fbias, bf16* Y) {
    LAS unsigned* cpk = (LAS unsigned*)((LAS unsigned char*)shm + fox_body::LDS_CPK); LAS float* wtot = (LAS float*)((LAS unsigned char*)shm + fox_body::LDS_TOTAL);
    for (int p = blockIdx.x; p < BATCH * 4 * 4; p += gridDim.x) {
        const int bh = p >> 2, s = p & 3, b = bh >> 2, h = bh & 3; const size_t rb = (size_t)b * SEQ;
        __syncthreads();
        { const int tid = ltid(), lane = tid & 63, wid = tid >> 6;
          float ls[4]; float run = 0.f; const float fbh = fbias[h];
#pragma unroll
          for (int i = 0; i < 4; ++i) ls[i] = SMALL[(rb + 4 * tid + i) * 16 + h];
          asm volatile("" ::: "memory");
#pragma unroll
          for (int i = 0; i < 4; ++i) { run += logsigmoidf_(ls[i] + fbh); ls[i] = run; }
          float inc = run;
#pragma unroll
          for (int o = 1; o < 64; o <<= 1) { const float t = lane_get(inc, lane - o); if (lane >= o) inc += t; }
          if (lane == 63) wtot[wid] = inc;
          __syncthreads();
          float base = inc - run;
          for (int w = 0; w < wid; ++w) base += wtot[w];
#pragma unroll
          for (int i = 0; i < 4; ++i) { const float neg = -(base + ls[i]) * LOG2E; const unsigned hi = f2bf(neg); const unsigned lo = f2bf(neg - __uint_as_float(hi << 16)); cpk[4 * tid + i] = hi | (lo << 16); } }
        __syncthreads();
        const fox_body::bf16* P = (const fox_body::bf16*)PROJ;
        fox_body::attn_unit<8>(b, 0, 7 - s, P + h * 64, P + 256 + h * 64, P + 512 + h * 64, (fox_body::bf16*)Y + h * 64, shm);
        fox_body::attn_unit<8>(b, 0, s, P + h * 64, P + 256 + h * 64, P + 512 + h * 64, (fox_body::bf16*)Y + h * 64, shm);
    }
    __syncthreads();
}


namespace mls {
typedef short v4i16 __attribute__((ext_vector_type(4)));
constexpr int QP = 72, VP = 88;
constexpr int O_Q = 0, O_K = 64 * QP * 2, O_V = 2 * 64 * QP * 2, BUF = O_V + 64 * VP * 2;
constexpr int O_PS = 2 * BUF, O_CT = O_PS + 64 * QP * 2, CTB = 80 * QP * 2, O_B2 = O_CT + 2 * CTB, O_U2 = O_B2 + 8192, O_UU = O_U2 + 8192, O_CH = O_UU + 8192, LDS_END = O_CH + 5 * 128;
static_assert(LDS_END <= 131072, "mLSTM LDS map");
__device__ __forceinline__ bf16x8 trfrag(const LAS bf16* base, int pitch, int row0, int col0, int fr, int fq) {
    const LAS bf16* p = base + (row0 + 8 * fq + (fr >> 2)) * pitch + col0 + 4 * (fr & 3);
    const v4i16 a = __builtin_amdgcn_ds_read_tr16_b64_v4i16((LAS v4i16*)p), b = __builtin_amdgcn_ds_read_tr16_b64_v4i16((LAS v4i16*)(p + 4 * pitch));
    return (bf16x8){a[0], a[1], a[2], a[3], b[0], b[1], b[2], b[3]};
}
__device__ __forceinline__ void unit(LAS unsigned char* L, int bh, int part, const bf16* PROJ, const float* SMALL, const float* ib, const float* fb, const float* hg, bf16* Y) {
    const int tid = ltid(), lane = tid & 63, wid = __builtin_amdgcn_readfirstlane(tid >> 6), fr = lane & 15, fq = lane >> 4;
    const int c_lo = part == 0 ? 0 : part == 1 ? 13 : part == 2 ? 22 : 28, c_hi = part == 0 ? 13 : part == 1 ? 22 : part == 2 ? 28 : 32;
    const int b = bh >> 2, h = bh & 3; const size_t rb = (size_t)b * SEQ;
    LAS float* B2 = (LAS float*)(L + O_B2); LAS float* U2 = (LAS float*)(L + O_U2); LAS float* UU = (LAS float*)(L + O_UU);
    LAS float* blast2 = (LAS float*)(L + O_CH); LAS float* umax2 = blast2 + 32; LAS float* mprev2 = blast2 + 64; LAS float* decay = blast2 + 96; LAS float* wl = blast2 + 128;
    const int lrow = tid >> 3, lc16 = tid & 7;
    const bf16* gsrc = PROJ + (rb + lrow) * NPROJ + 64 * h + 8 * lc16;
    const v4u q0_ = *(const v4u*)(gsrc + 1536), k0_ = *(const v4u*)(gsrc + 1792), v0_ = *(const v4u*)(gsrc + 2048);
    f32x4 gain4[4];
#pragma unroll
    for (int et = 0; et < 4; ++et) gain4[et] = *(const f32x4*)(hg + 64 * h + 16 * et + 4 * fq);
    __syncthreads();
    for (int i = tid; i < 2 * 64 * 16; i += 512) { const int bu = i >> 10, r = (i >> 4) & 63, c = i & 15; ((LAS bf16*)(L + bu * BUF + O_V))[r * VP + 64 + c] = c == 0 ? (bf16)0x3f80 : (bf16)0; }
    for (int i = tid; i < CTB / 4; i += 512) ((LAS unsigned*)(L + O_CT))[i] = 0u;
    float fpre[4], ipre[4];
#pragma unroll
    for (int j = 0; j < 4; ++j) { const size_t row = rb + 64 * (wid + 8 * j) + lane; fpre[j] = SMALL[row * 16 + 8 + h]; ipre[j] = SMALL[row * 16 + 4 + h]; }
#pragma unroll
    for (int j = 0; j < 4; ++j) {
        const int c = wid + 8 * j;
        const float lf = logsigmoidf_(fpre[j] + fb[h]), li = ipre[j] + ib[h];
        float bs = lf;
#pragma unroll
        for (int o = 1; o < 64; o <<= 1) { const float t = lane_get(bs, lane - o); if (lane >= o) bs += t; }
        const float u = li - bs; float U = u;
#pragma unroll
        for (int o = 1; o < 64; o <<= 1) { const float t = lane_get(U, lane - o); if (lane >= o) U = fmaxf(U, t); }
        B2[64 * c + lane] = bs * LOG2E; U2[64 * c + lane] = u * LOG2E; UU[64 * c + lane] = U * LOG2E;
        if (lane == 63) { blast2[c] = bs * LOG2E; umax2[c] = U * LOG2E; }
    }
    __syncthreads();
    if (wid == 0) {
        const int c = lane & 31; const float bl = blast2[c], ml = bl + umax2[c]; float A = bl, B = ml;
#pragma unroll
        for (int o = 1; o < 32; o <<= 1) { const float Ap = lane_get(A, lane - o), Bp = lane_get(B, lane - o); if (c >= o) { B = fmaxf(Bp + A, B); A = Ap + A; } }
        const float mn = fmaxf(A, B); float mp = lane_get(mn, lane - 1); if (c == 0) mp = 0.f;
        if (lane < 32) { mprev2[c] = mp; decay[c] = exp2f(bl + mp - mn); wl[c] = exp2f(ml - mn); } }
    { *(LAS v4u*)((LAS bf16*)(L + O_Q) + lrow * QP + 8 * lc16) = q0_; *(LAS v4u*)((LAS bf16*)(L + O_K) + lrow * QP + 8 * lc16) = k0_; *(LAS v4u*)((LAS bf16*)(L + O_V) + lrow * VP + 8 * lc16) = v0_; }
    f32x4 Cst[5];
#pragma unroll
    for (int et = 0; et < 5; ++et) Cst[et] = (f32x4){0.f, 0.f, 0.f, 0.f};
    v2u ogc[4] = {{0u, 0u}, {0u, 0u}, {0u, 0u}, {0u, 0u}};
    const bf16* ogsrc = PROJ + (rb + 16 * (wid & 3) + fr) * NPROJ + 2304 + 64 * h + 4 * fq;
    if (wid < 4 && c_lo == 0) {
#pragma unroll
        for (int et = 0; et < 4; ++et) ogc[et] = *(const v2u*)(ogsrc + 16 * et); }
    __syncthreads();
#pragma unroll 1
    for (int c = 0; c < c_hi; ++c) {
        const bool full = c >= c_lo;
        const int cur = c & 1; LAS unsigned char* Lb = L + cur * BUF;
        const LAS bf16* Qs = (const LAS bf16*)(Lb + O_Q); const LAS bf16* Ks = (const LAS bf16*)(Lb + O_K); const LAS bf16* Vs = (const LAS bf16*)(Lb + O_V);
        LAS bf16* Ps = (LAS bf16*)(L + O_PS); const LAS bf16* Ctc = (const LAS bf16*)(L + O_CT + cur * CTB); LAS bf16* Ctn = (LAS bf16*)(L + O_CT + (cur ^ 1) * CTB);
        v4u nq, nk, nv; const bool more = c + 1 < c_hi;
        if (more) { const bf16* g2 = gsrc + (size_t)64 * (c + 1) * NPROJ; nq = *(const v4u*)(g2 + 1536); nk = *(const v4u*)(g2 + 1792); nv = *(const v4u*)(g2 + 2048); }
        const float mp2 = mprev2[c];
        if (full) { const int tt = wid >> 1, t = 16 * tt + fr; const float M2t = fmaxf(mp2, UU[64 * c + t]);
#pragma unroll
          for (int si = 0; si < 2; ++si) { const int st = 2 * (wid & 1) + si, s0 = 16 * st + 4 * fq; v2u w = {0u, 0u};
              if (st <= tt) { f32x4 acc = {0.f, 0.f, 0.f, 0.f};
#pragma unroll
                  for (int ks = 0; ks < 2; ++ks) { const bf16x8 a = *(const LAS bf16x8*)(Ks + (16 * st + fr) * QP + 32 * ks + 8 * fq), bq = *(const LAS bf16x8*)(Qs + (16 * tt + fr) * QP + 32 * ks + 8 * fq);
                      acc = __builtin_amdgcn_mfma_f32_16x16x32_bf16(a, bq, acc, 0, 0, 0); }
                  const f32x4 u4 = *(const LAS f32x4*)(U2 + 64 * c + s0); float p[4];
#pragma unroll
                  for (int e = 0; e < 4; ++e) p[e] = (s0 + e <= t) ? acc[e] * 0.125f * __builtin_amdgcn_exp2f(u4[e] - M2t) : 0.f;
                  w.x = pk2(p[0], p[1]); w.y = pk2(p[2], p[3]); }
              *(LAS v2u*)(Ps + t * QP + s0) = w; }
          __syncthreads(); }
        if (wid < 4) { if (full) {
            const int t = 16 * wid + fr; const size_t row = rb + 64 * c + t;
            f32x4 aP[5], aQ[5];
#pragma unroll
            for (int et = 0; et < 5; ++et) { aP[et] = (f32x4){0.f, 0.f, 0.f, 0.f}; aQ[et] = (f32x4){0.f, 0.f, 0.f, 0.f}; }
#pragma unroll
            for (int ks = 0; ks < 2; ++ks) {
                const bf16x8 bp = *(const LAS bf16x8*)(Ps + t * QP + 32 * ks + 8 * fq), bq = *(const LAS bf16x8*)(Qs + t * QP + 32 * ks + 8 * fq); bf16x8 av[5], ac[5];
#pragma unroll
                for (int et = 0; et < 5; ++et) { av[et] = trfrag(Vs, VP, 32 * ks, 16 * et, fr, fq); ac[et] = *(const LAS bf16x8*)(Ctc + (16 * et + fr) * QP + 32 * ks + 8 * fq); }
                __builtin_amdgcn_sched_barrier(0); asm volatile("s_waitcnt lgkmcnt(0)" ::: "memory"); __builtin_amdgcn_sched_barrier(0);
#pragma unroll
                for (int et = 0; et < 5; ++et) { aP[et] = __builtin_amdgcn_mfma_f32_16x16x32_bf16(av[et], bp, aP[et], 0, 0, 0); aQ[et] = __builtin_amdgcn_mfma_f32_16x16x32_bf16(ac[et], bq, aQ[et], 0, 0, 0); }
                __builtin_amdgcn_sched_barrier(0); }
            const float M2t = fmaxf(mp2, UU[64 * c + t]), inter8 = __builtin_amdgcn_exp2f(mp2 - M2t) * 0.125f, flo = __builtin_amdgcn_exp2f(-(B2[64 * c + t] + M2t));
            const float den = sum_fq(fq == 0 ? aP[4][0] + inter8 * aQ[4][0] : 0.f); const float dd = 1.f / fmaxf(fabsf(den), flo);
            f32x4 hv[4]; float ss = 0.f;
#pragma unroll
            for (int et = 0; et < 4; ++et) { hv[et] = (aP[et] + inter8 * aQ[et]) * dd; ss += (hv[et][0] * hv[et][0] + hv[et][1] * hv[et][1]) + (hv[et][2] * hv[et][2] + hv[et][3] * hv[et][3]); }
            ss = sum_fq(ss);
            const float rinv = rsqrtf(ss * (1.f / 64.f) + EPS);
#pragma unroll
            for (int et = 0; et < 4; ++et) { const f32x4 o4 = {bflo(ogc[et].x), bfhi(ogc[et].x), bflo(ogc[et].y), bfhi(ogc[et].y)}; f32x4 y;
#pragma unroll
                for (int e = 0; e < 4; ++e) y[e] = sigmoidf_(o4[e]) * hv[et][e] * rinv * gain4[et][e];
                v2u w; w.x = pk2(y[0], y[1]); w.y = pk2(y[2], y[3]); *(v2u*)(Y + row * YW + 512 + 64 * h + 16 * et + 4 * fq) = w; }
        } } else {
            const int dt = wid - 4; const float um = umax2[c], dc = decay[c], wlc = wl[c]; bf16x8 ak[2];
#pragma unroll
            for (int ks = 0; ks < 2; ++ks) { const bf16x8 kr = trfrag(Ks, QP, 32 * ks, 16 * dt, fr, fq); const f32x4 ua = *(const LAS f32x4*)(U2 + 64 * c + 32 * ks + 8 * fq), ub = *(const LAS f32x4*)(U2 + 64 * c + 32 * ks + 8 * fq + 4);
                float kw[8];
#pragma unroll
                for (int e = 0; e < 4; ++e) { kw[e] = bf2f((bf16)kr[e]) * __builtin_amdgcn_exp2f(ua[e] - um); kw[4 + e] = bf2f((bf16)kr[4 + e]) * __builtin_amdgcn_exp2f(ub[e] - um); }
                const v4u pk = {pk2(kw[0], kw[1]), pk2(kw[2], kw[3]), pk2(kw[4], kw[5]), pk2(kw[6], kw[7])}; ak[ks] = __builtin_bit_cast(bf16x8, pk); }
            bf16x8 vf[5][2];
#pragma unroll
            for (int et = 0; et < 5; ++et)
#pragma unroll
                for (int ks = 0; ks < 2; ++ks) vf[et][ks] = trfrag(Vs, VP, 32 * ks, 16 * et, fr, fq);
            __builtin_amdgcn_sched_barrier(0); asm volatile("s_waitcnt lgkmcnt(0)" ::: "memory"); __builtin_amdgcn_sched_barrier(0);
#pragma unroll
            for (int et = 0; et < 5; ++et) { f32x4 acc = {0.f, 0.f, 0.f, 0.f};
#pragma unroll
                for (int ks = 0; ks < 2; ++ks) acc = __builtin_amdgcn_mfma_f32_16x16x32_bf16(ak[ks], vf[et][ks], acc, 0, 0, 0);
                Cst[et] = Cst[et] * dc + acc * wlc;
                v2u w; w.x = pk2(Cst[et][0], Cst[et][1]); w.y = pk2(Cst[et][2], Cst[et][3]); *(LAS v2u*)(Ctn + (16 * et + fr) * QP + 16 * dt + 4 * fq) = w; }
        }
        if (more) { LAS unsigned char* Ln = L + (cur ^ 1) * BUF;
            *(LAS v4u*)((LAS bf16*)(Ln + O_Q) + lrow * QP + 8 * lc16) = nq; *(LAS v4u*)((LAS bf16*)(Ln + O_K) + lrow * QP + 8 * lc16) = nk; *(LAS v4u*)((LAS bf16*)(Ln + O_V) + lrow * VP + 8 * lc16) = nv; }
        if (wid < 4 && more && c + 1 >= c_lo) {
#pragma unroll
            for (int et = 0; et < 4; ++et) ogc[et] = *(const v2u*)(ogsrc + (size_t)64 * (c + 1) * NPROJ + 16 * et); }
        __syncthreads();
    }
}
}
__device__ __forceinline__ void mlstm_phase(LAS unsigned char* L, const bf16* PROJ, const float* SMALL, const float* ib, const float* fb, const float* hg, bf16* Y) {
    for (int u = blockIdx.x; u < BATCH * 4 * 4; u += gridDim.x) mls::unit(L, u >> 2, u & 3, PROJ, SMALL, ib, fb, hg, Y);
    __syncthreads();
}


namespace swa {
typedef short v4i16 __attribute__((ext_vector_type(4)));
constexpr int KP = 72, PP = 40;
constexpr int O_K = 0, O_V = 256 * KP * 2, O_P = 2 * O_V, PWB = 32 * PP * 2, O_BT = O_P + 8 * PWB, LDS_END = O_BT + 4 * 128 * 4;
static_assert(LDS_END <= 131072, "SWA LDS map");
__device__ __forceinline__ int t5_bucket(int n) { if (n < 16) return n; const int l = 16 + (int)(logf((float)n / 16.f) / logf(8.f) * 16.f); return l < 31 ? l : 31; }
__device__ __forceinline__ void unit(LAS unsigned char* L, int u, const bf16* PROJ, const float* relb, const float* sinks, bf16* Y) {
    const int tid = ltid(), lane = tid & 63, wid = __builtin_amdgcn_readfirstlane(tid >> 6), fr = lane & 15, fq = lane >> 4;
    const int b = u >> 5, kvh = (u >> 4) & 1, n = u & 15; const size_t rb = (size_t)b * SEQ;
    LAS bf16* Kb = (LAS bf16*)(L + O_K); LAS bf16* Vb = (LAS bf16*)(L + O_V); LAS bf16* Pw = (LAS bf16*)(L + O_P + wid * PWB); LAS float* BT = (LAS float*)(L + O_BT);
    bf16x8 qf[2][2][2];
#pragma unroll
    for (int tk = 0; tk < 2; ++tk) { const int task = 2 * wid + tk, hq_ = 4 * kvh + (task >> 2), i0_ = 32 * (task & 3);
#pragma unroll
        for (int qt = 0; qt < 2; ++qt)
#pragma unroll
            for (int ks = 0; ks < 2; ++ks) qf[tk][qt][ks] = *(const bf16x8*)(PROJ + (rb + 128 * n + i0_ + 16 * qt + fr) * NPROJ + 2560 + 64 * hq_ + 32 * ks + 8 * fq); }
    __syncthreads();
    BT[tid] = relb[t5_bucket(tid & 127) * 8 + 4 * kvh + (tid >> 7)] * LOG2E;
    v4u kb_[4], vb_[4];
#pragma unroll
    for (int i = 0; i < 4; ++i) { const int idx = tid + 512 * i, prow = idx >> 3, c16 = idx & 7, s = 128 * (n - 1) + prow; v4u kk, vv;
        { const bf16* g = PROJ + (rb + (s < 0 ? 0 : s)) * NPROJ + 64 * kvh + 8 * c16; kk = *(const v4u*)(g + 3072); vv = *(const v4u*)(g + 3200); }
        kb_[i] = kk; vb_[i] = vv; }
#pragma unroll
    for (int i = 0; i < 4; ++i) { const int idx = tid + 512 * i, prow = idx >> 3, c16 = idx & 7, s = 128 * (n - 1) + prow; const v4u z = {0u, 0u, 0u, 0u};
        *(LAS v4u*)(Kb + prow * KP + 8 * c16) = s < 0 ? z : kb_[i]; *(LAS v4u*)(Vb + prow * KP + 8 * c16) = s < 0 ? z : vb_[i]; }
    __syncthreads();
#pragma unroll
    for (int tk = 0; tk < 2; ++tk) {
        const int task = 2 * wid + tk, g = task >> 2, i0 = 32 * (task & 3), hq = 4 * kvh + g; const float sink2 = sinks[hq] * LOG2E;
        bf16x8 q[2][2];
#pragma unroll
        for (int qt = 0; qt < 2; ++qt)
#pragma unroll
            for (int ks = 0; ks < 2; ++ks) q[qt][ks] = qf[tk][qt][ks];
        f32x4 sc[2][10];
#pragma unroll
        for (int hb = 0; hb < 2; ++hb) {
            bf16x8 ka[5][2];
#pragma unroll
            for (int k5 = 0; k5 < 5; ++k5)
#pragma unroll
                for (int ks = 0; ks < 2; ++ks) ka[k5][ks] = *(const LAS bf16x8*)(Kb + (i0 + 16 * (5 * hb + k5) + fr) * KP + 32 * ks + 8 * fq);
            __builtin_amdgcn_sched_barrier(0); asm volatile("s_waitcnt lgkmcnt(0)" ::: "memory"); __builtin_amdgcn_sched_barrier(0);
#pragma unroll
            for (int k5 = 0; k5 < 5; ++k5) { const int kt = 5 * hb + k5;
                if (kt < 9) { sc[0][kt] = __builtin_amdgcn_mfma_f32_16x16x32_bf16(ka[k5][0], q[0][0], (f32x4){0.f, 0.f, 0.f, 0.f}, 0, 0, 0); sc[0][kt] = __builtin_amdgcn_mfma_f32_16x16x32_bf16(ka[k5][1], q[0][1], sc[0][kt], 0, 0, 0); }
                if (kt > 0) { sc[1][kt] = __builtin_amdgcn_mfma_f32_16x16x32_bf16(ka[k5][0], q[1][0], (f32x4){0.f, 0.f, 0.f, 0.f}, 0, 0, 0); sc[1][kt] = __builtin_amdgcn_mfma_f32_16x16x32_bf16(ka[k5][1], q[1][1], sc[1][kt], 0, 0, 0); } }
            __builtin_amdgcn_sched_barrier(0);
        }
        float linv[2];
        sc[0][9] = (f32x4){0.f, 0.f, 0.f, 0.f}; sc[1][0] = (f32x4){0.f, 0.f, 0.f, 0.f};
        if (n == 0) {
#pragma unroll
            for (int qt = 0; qt < 2; ++qt)
#pragma unroll
                for (int kt = 0; kt < 10; ++kt) if (kt - qt >= 0 && kt - qt <= 8)
#pragma unroll
                    for (int e = 0; e < 4; ++e) if (i0 + 16 * kt + 4 * fq + e < 128) sc[qt][kt][e] = -INFINITY;
        }
        const int D0 = 128 + fr - 4 * fq; const LAS float* bt = BT + g * 128;
#pragma unroll
        for (int qt = 0; qt < 2; ++qt) {
            float m = sink2;
#pragma unroll
            for (int kt = 0; kt < 10; ++kt) { const int dl = kt - qt; if (dl < 0 || dl > 8) continue;
#pragma unroll
                for (int e = 0; e < 4; ++e) { const int dist = D0 - 16 * dl - e; float x;
                    if (dl == 0) x = dist < 128 ? sc[qt][kt][e] + bt[dist & 127] : -INFINITY; else if (dl == 8) x = dist >= 0 ? sc[qt][kt][e] + bt[dist & 127] : -INFINITY; else x = sc[qt][kt][e] + bt[dist];
                    sc[qt][kt][e] = x; m = fmaxf(m, x); } }
            m = max_fq(m);
            float l = 0.f;
#pragma unroll
            for (int kt = 0; kt < 10; ++kt) { const int dl = kt - qt; if (dl < 0 || dl > 8) continue;
#pragma unroll
                for (int e = 0; e < 4; ++e) { const float pe = __builtin_amdgcn_exp2f(sc[qt][kt][e] - m); sc[qt][kt][e] = pe; l += pe; } }
            l = sum_fq(l); l += __builtin_amdgcn_exp2f(sink2 - m);
            linv[qt] = 1.f / l;
        }
        f32x4 o[2][4];
#pragma unroll
        for (int qt = 0; qt < 2; ++qt)
#pragma unroll
            for (int dt = 0; dt < 4; ++dt) o[qt][dt] = (f32x4){0.f, 0.f, 0.f, 0.f};
#pragma unroll
        for (int r = 0; r < 5; ++r) {
            v4i16 va[4], vb[4];
#pragma unroll
            for (int dt = 0; dt < 4; ++dt) { const LAS bf16* vp = Vb + (i0 + 32 * r + 8 * fq + (fr >> 2)) * KP + 16 * dt + 4 * (fr & 3);
                va[dt] = __builtin_amdgcn_ds_read_tr16_b64_v4i16((LAS v4i16*)vp); vb[dt] = __builtin_amdgcn_ds_read_tr16_b64_v4i16((LAS v4i16*)(vp + 4 * KP)); }
#pragma unroll
            for (int qt = 0; qt < 2; ++qt)
#pragma unroll
                for (int kk = 0; kk < 2; ++kk) { const f32x4 pv = sc[qt][2 * r + kk]; v2u w; w.x = pk2(pv[0], pv[1]); w.y = pk2(pv[2], pv[3]); *(LAS v2u*)(Pw + (16 * qt + fr) * PP + 16 * kk + 4 * fq) = w; }
            asm volatile("s_waitcnt lgkmcnt(0)" ::: "memory");
            const bf16x8 p0 = *(const LAS bf16x8*)(Pw + fr * PP + 8 * fq), p1 = *(const LAS bf16x8*)(Pw + (16 + fr) * PP + 8 * fq);
            __builtin_amdgcn_sched_barrier(0); asm volatile("s_waitcnt lgkmcnt(0)" ::: "memory"); __builtin_amdgcn_sched_barrier(0);
#pragma unroll
            for (int dt = 0; dt < 4; ++dt) { const bf16x8 av = {va[dt][0], va[dt][1], va[dt][2], va[dt][3], vb[dt][0], vb[dt][1], vb[dt][2], vb[dt][3]};
                o[0][dt] = __builtin_amdgcn_mfma_f32_16x16x32_bf16(av, p0, o[0][dt], 0, 0, 0); o[1][dt] = __builtin_amdgcn_mfma_f32_16x16x32_bf16(av, p1, o[1][dt], 0, 0, 0); }
            __builtin_amdgcn_sched_barrier(0);
        }
#pragma unroll
        for (int qt = 0; qt < 2; ++qt)
#pragma unroll
            for (int dt = 0; dt < 4; ++dt) { const f32x4 y = o[qt][dt] * linv[qt]; v2u w; w.x = pk2(y[0], y[1]); w.y = pk2(y[2], y[3]);
                *(v2u*)(Y + (rb + 128 * n + i0 + 16 * qt + fr) * YW + 768 + 64 * hq + 16 * dt + 4 * fq) = w; }
    }
}
}
__device__ __forceinline__ void swa_phase(LAS unsigned char* L, const bf16* PROJ, const float* relb, const float* sinks, bf16* Y) {
    for (int u = blockIdx.x; u < BATCH * 2 * 16; u += gridDim.x) swa::unit(L, u, PROJ, relb, sinks, Y);
    __syncthreads();
}
__device__ __forceinline__ void conv_phase(const bf16* PROJ, const float* cw, bf16* Y) {
    for (size_t idx = (size_t)blockIdx.x * 512 + ltid(); idx < (size_t)(M / 4) * 32; idx += (size_t)gridDim.x * 512) {
        const int cg = idx & 31; const size_t row0 = (idx >> 5) * 4; const int t0 = row0 % SEQ;
        v4u uu[6], cc[6], bb[4];
#pragma unroll
        for (int j = 0; j < 6; ++j) { const bool ok = t0 + j - 2 >= 0; const bf16* p = PROJ + (row0 + (ok ? j - 2 : 0)) * NPROJ + 8 * cg; uu[j] = *(const v4u*)(p + 768); cc[j] = *(const v4u*)(p + 1280);
            if (!ok) { uu[j] = (v4u){0u, 0u, 0u, 0u}; } }
#pragma unroll
        for (int j = 0; j < 4; ++j) bb[j] = *(const v4u*)(PROJ + (row0 + j) * NPROJ + 1024 + 8 * cg);
        f32x4 w[3][2];
#pragma unroll
        for (int k = 0; k < 3; ++k) { w[k][0] = *(const f32x4*)(cw + k * 256 + 8 * cg); w[k][1] = *(const f32x4*)(cw + k * 256 + 8 * cg + 4); }
        float z[6][8];
#pragma unroll
        for (int j = 0; j < 6; ++j) { z[j][0] = bflo(uu[j].x) * bflo(cc[j].x); z[j][1] = bfhi(uu[j].x) * bfhi(cc[j].x); z[j][2] = bflo(uu[j].y) * bflo(cc[j].y); z[j][3] = bfhi(uu[j].y) * bfhi(cc[j].y);
            z[j][4] = bflo(uu[j].z) * bflo(cc[j].z); z[j][5] = bfhi(uu[j].z) * bfhi(cc[j].z); z[j][6] = bflo(uu[j].w) * bflo(cc[j].w); z[j][7] = bfhi(uu[j].w) * bfhi(cc[j].w); }
#pragma unroll
        for (int j = 0; j < 4; ++j) { float a[8];
#pragma unroll
            for (int e = 0; e < 8; ++e) a[e] = w[0][e >> 2][e & 3] * z[j][e] + w[1][e >> 2][e & 3] * z[j + 1][e] + w[2][e >> 2][e & 3] * z[j + 2][e];
            v4u o; o.x = pk2(a[0] * bflo(bb[j].x), a[1] * bfhi(bb[j].x)); o.y = pk2(a[2] * bflo(bb[j].y), a[3] * bfhi(bb[j].y)); o.z = pk2(a[4] * bflo(bb[j].z), a[5] * bfhi(bb[j].z)); o.w = pk2(a[6] * bflo(bb[j].w), a[7] * bfhi(bb[j].w));
            *(v4u*)(Y + (row0 + j) * YW + 256 + 8 * cg) = o; }
    }
}

__device__ __forceinline__ int colmap_in(int lc) {
    if (lc < 768) return lc;
    if (lc < 1536) return 772 + (lc - 768);
    if (lc < 2304) return 1540 + (lc - 1536);
    if (lc < 2560) return 2316 + (lc - 2304);
    if (lc < 3328) return 2572 + (lc - 2560);
    if (lc < 3332) return 768 + (lc - 3328);
    if (lc < 3340) return 2308 + (lc - 3332);
    if (lc < GATE0) return -1;
    return 3340 + (lc - GATE0);
}
struct TrItem { const float* W; const float* sc; unsigned char* WT; unsigned ldw, ldt; int srccol, n0, k0, f8; };
__device__ __forceinline__ void tr_load(const TrItem& d, float (&v)[32], float& scv, int lane) {
    scv = d.sc ? d.sc[d.k0 + lane] : 1.f;
    const int col = d.srccol < 0 ? 0 : d.srccol;
#pragma unroll
    for (int i = 0; i < 32; ++i) { const int kk = 2 * i + (lane >> 5); v[i] = __builtin_nontemporal_load(d.W + (size_t)(d.k0 + kk) * d.ldw + col); }
}
__device__ __forceinline__ void tr_store(const TrItem& d, const float (&v)[32], float scv, LAS float* scr, int lane) {
    scv *= d.f8 ? 64.f : 1.f; const bool hi = lane >= 32; const float zf = d.srccol < 0 ? 0.f : 1.f;
#pragma unroll
    for (int i = 0; i < 32; ++i) { const int kk = 2 * i + (lane >> 5); const float s0 = __int_as_float(__builtin_amdgcn_readlane(__float_as_int(scv), 2 * i)), s1 = __int_as_float(__builtin_amdgcn_readlane(__float_as_int(scv), 2 * i + 1)); scr[kk * 33 + (lane & 31)] = v[i] * ((hi ? s1 : s0) * zf); }
    asm volatile("s_waitcnt lgkmcnt(0)" ::: "memory");
    if (!d.f8) { const int c = lane & 7;
#pragma unroll
        for (int j = 0; j < 4; ++j) { const int n = (lane >> 3) + 8 * j; const LAS float* s = scr + (8 * c) * 33 + n;
            v4u o; o.x = pk2(s[0 * 33], s[1 * 33]); o.y = pk2(s[2 * 33], s[3 * 33]); o.z = pk2(s[4 * 33], s[5 * 33]); o.w = pk2(s[6 * 33], s[7 * 33]);
            *(v4u*)((bf16*)d.WT + (size_t)(d.n0 + n) * d.ldt + d.k0 + 8 * c) = o; } }
    else { const int c = lane & 3;
#pragma unroll
        for (int j = 0; j < 2; ++j) { const int n = (lane >> 2) + 16 * j; const LAS float* s = scr + (16 * c) * 33 + n;
            v4u o; o.x = pk4_f8(s[0 * 33], s[1 * 33], s[2 * 33], s[3 * 33]); o.y = pk4_f8(s[4 * 33], s[5 * 33], s[6 * 33], s[7 * 33]); o.z = pk4_f8(s[8 * 33], s[9 * 33], s[10 * 33], s[11 * 33]); o.w = pk4_f8(s[12 * 33], s[13 * 33], s[14 * 33], s[15 * 33]);
            *(v4u*)(d.WT + (size_t)(d.n0 + n) * D + d.k0 + 16 * c) = o; } }
    asm volatile("s_waitcnt lgkmcnt(0)" ::: "memory");
}

struct Args { const float* in[23]; float* out; unsigned char* ws; int ph_lo, ph_hi; };
#ifndef DUP_PH
#define DUP_PH -1
#endif
#define REPS(k) ((DUP_PH) == (k) ? 2 : 1)
#ifndef MK_PER_PHASE
#define MK_PER_PHASE 0
#endif

__device__ __forceinline__ const float* inp_(int i) { unsigned o = (unsigned)i * 8u; asm volatile("" : "+s"(o)); return *(const float* const __attribute__((address_space(4)))*)((const __attribute__((address_space(4))) char*)__builtin_amdgcn_kernarg_segment_ptr() + o); }
#define INP(i) inp_(i)
__device__ __forceinline__ unsigned char* kptr_(unsigned off) { asm volatile("" : "+s"(off)); return *(unsigned char* const __attribute__((address_space(4)))*)((const __attribute__((address_space(4))) char*)__builtin_amdgcn_kernarg_segment_ptr() + off); }
#define WSP() kptr_(192)
#define OUTP() ((float*)kptr_(184))
#define PTRS0 unsigned char* ws = WSP(); bf16 *XA = (bf16*)(ws + WS_XA), *XB = (bf16*)(ws + WS_XB), *Y = (bf16*)(ws + WS_Y), *PROJ = (bf16*)(ws + WS_PROJ), *ACT = (bf16*)(ws + WS_ACT); float *SMALL = (float*)(ws + WS_SMALL), *SSQ = (float*)(ws + WS_SSQ); const int G = gridDim.x; (void)XA; (void)XB; (void)Y; (void)PROJ; (void)ACT; (void)SMALL; (void)SSQ; (void)G
#define PTRS PTRS0; unsigned char* wl = ws + WS_W + (size_t)l * W_LAYER; const bf16 *WIN = (const bf16*)(wl + OFF_WIN), *WBR = (const bf16*)(wl + OFF_WBR), *WMO = (const bf16*)(wl + OFF_WMO), *WGU = (const bf16*)(wl + OFF_WGU), *WD = (const bf16*)(wl + OFF_WD); (void)WIN; (void)WBR; (void)WMO; (void)WGU; (void)WD
constexpr int TR_I_IN = 16 * (NIN / 32), TR_I_BR = 20 * 32, TR_I_MO = 16 * 32, TR_I_GU = 16 * (2 * DFF / 32), TR_I_D = 44 * 32, TR_I_L = TR_I_IN + TR_I_BR + TR_I_MO + TR_I_GU + TR_I_D;
__device__ __forceinline__ TrItem tr_decode(int it, int lane, unsigned char* ws) {
    TrItem d; const int l = it / TR_I_L; int r = it % TR_I_L; unsigned char* wl = ws + WS_W + (size_t)l * W_LAYER; d.f8 = 0; d.sc = nullptr;
    if (r < TR_I_IN) { const int kb = r / (NIN / 32), nb = r % (NIN / 32); d.srccol = colmap_in(32 * nb + (lane & 31)); d.W = INP(3) + (size_t)l * D * IN_COLS; d.ldw = IN_COLS; d.sc = INP(2) + l * D; d.k0 = 64 * kb;
        if (32 * nb >= GATE0) { d.f8 = 1; d.WT = ws + WS_W8 + (size_t)l * 4 * MiB; d.ldt = D; d.n0 = 32 * nb - GATE0; }
        else { d.WT = wl + OFF_WIN; d.ldt = D; d.n0 = 32 * nb; }
        return d; } r -= TR_I_IN;
    if (r < TR_I_BR) { const int kb = r / 32, nb = r % 32; const int k0 = 64 * kb; const float* W; int kk0;
        if (k0 < 256) { W = INP(14) + (size_t)l * 256 * D; kk0 = k0; } else if (k0 < 512) { W = INP(15) + (size_t)l * 256 * D; kk0 = k0 - 256; }
        else if (k0 < 768) { W = INP(16) + (size_t)l * 256 * D; kk0 = k0 - 512; } else { W = INP(17) + (size_t)l * 512 * D; kk0 = k0 - 768; }
        d.W = W + (size_t)kk0 * D - (size_t)k0 * D; d.ldw = D; d.srccol = 32 * nb + (lane & 31); d.WT = wl + OFF_WBR; d.ldt = YW; d.n0 = 32 * nb; d.k0 = k0; return d; } r -= TR_I_BR;
    if (r < TR_I_MO) { const int kb = r / 32, nb = r % 32;
        d.W = INP(18) + (size_t)l * D * D; d.ldw = D; d.srccol = 32 * nb + (lane & 31); d.WT = wl + OFF_WMO; d.ldt = D; d.n0 = 32 * nb; d.k0 = 64 * kb; return d; } r -= TR_I_MO;
    if (r < TR_I_GU) { const int kb = r / (2 * DFF / 32), nb = r % (2 * DFF / 32); const int n = 32 * nb, pn = n / 256, rr = n % 256, wc = rr / 64, bj = (rr % 64) / 32;
        d.W = (bj ? INP(21) : INP(20)) + (size_t)l * D * DFF; d.ldw = DFF; d.srccol = 128 * pn + 32 * wc + (lane & 31); d.sc = INP(19) + l * D; d.WT = wl + OFF_WGU; d.ldt = D; d.n0 = n; d.k0 = 64 * kb; return d; } r -= TR_I_GU;
    { const int kb = r / 32, nb = r % 32;
        d.W = INP(22) + (size_t)l * DFF * D; d.ldw = D; d.srccol = 32 * nb + (lane & 31); d.WT = wl + OFF_WD; d.ldt = DFF; d.n0 = 32 * nb; d.k0 = 64 * kb; return d; }
}
__device__ __forceinline__ void tr_weights(LAS unsigned char* lds, unsigned char* ws, int it0, int it1, int gw, int NGW, int wave, int lane) {
    LAS float* scr = (LAS float*)(lds + wave * 16384);
    float va[32], vb[32], sa = 1.f, sb = 1.f; TrItem da, db; int it = it0 + gw;
    if (it < it1) { da = tr_decode(it, lane, ws); tr_load(da, va, sa, lane); }
#pragma unroll 1
    for (; it < it1; it += 2 * NGW) {
        const bool hb = it + NGW < it1; if (hb) { db = tr_decode(it + NGW, lane, ws); tr_load(db, vb, sb, lane); }
        tr_store(da, va, sa, scr, lane);
        const bool ha = it + 2 * NGW < it1; if (ha) { da = tr_decode(it + 2 * NGW, lane, ws); tr_load(da, va, sa, lane); }
        if (hb) tr_store(db, vb, sb, scr, lane);
    }
}
__global__ void __launch_bounds__(NWAVES * 64, 2) fwd(Args args) {
    extern __shared__ __attribute__((aligned(16))) unsigned char lds_[];
    LAS unsigned char* lds = (LAS unsigned char*)lds_;
    { const int tid = threadIdx.x;
      for (int u = tid; u < (LDS_BYTES - LDSCTL_OFF) / 4; u += NWAVES * 64) ((LAS unsigned*)(lds + LDSCTL_OFF))[u] = 0u;
      __syncthreads();
      if ((tid & 63) == 0) ((LAS int*)(lds + WTAB_OFF))[hwkey_()] = tid >> 6; }
    __syncthreads();
    (void)xcd_barrier_post((unsigned*)(WSP() + WS_CTL) + CW_BAR, (volatile LAS unsigned*)(lds + MISC_OFF) + 8);
#define IN(k) (args.ph_lo <= (k) && (k) < args.ph_hi)
#define SEAM(k) do { if (IN(k) && IN((k) + 1)) { XcdBarrier b_; b_.bar = (unsigned*)(WSP() + WS_CTL) + CW_BAR; b_.x = xb_xcc_id(); b_.st = (volatile LAS unsigned*)(lds + MISC_OFF) + 8; for (int rb_ = 0; rb_ < REPS(50); ++rb_) xcd_barrier(b_); } } while (0)
    if (IN(0)) for (int rep_ = 0; rep_ < REPS(100); ++rep_) { PTRS0;
        const int tid = ltid(), lane = tid & 63, wave = __builtin_amdgcn_readfirstlane(tid >> 6); (void)tid;
        LAS float* scr = (LAS float*)(lds + wave * 16384);
        const int gw = blockIdx.x * NWAVES + wave, NGW = G * NWAVES;
        tr_weights(lds, ws, 0, DEPTH * TR_I_L, gw, NGW, wave, lane);
#pragma unroll 1
        for (int m0 = gw; m0 < M; m0 += 4 * NGW) {
            f32x4 v[4][4];
#pragma unroll
            for (int r = 0; r < 4; ++r) { const int m = m0 + r * NGW; if (m < M) { const f32x4* xr = (const f32x4*)(INP(0) + (size_t)m * D) + lane;
#pragma unroll
                for (int j = 0; j < 4; ++j) v[r][j] = __builtin_nontemporal_load(xr + 64 * j); } }
#pragma unroll
            for (int r = 0; r < 4; ++r) { const int m = m0 + r * NGW; if (m < M) { float s = 0.f; v2u* o8 = (v2u*)(XA + (size_t)m * D) + lane; unsigned* o4 = (unsigned*)((unsigned char*)OUTP() + OUT_XA8 + (size_t)m * D) + lane;
#pragma unroll
                for (int j = 0; j < 4; ++j) { const f32x4 x = v[r][j]; s += (x.x * x.x + x.y * x.y) + (x.z * x.z + x.w * x.w); v2u w; w.x = pk2(x.x, x.y); w.y = pk2(x.z, x.w); o8[64 * j] = w; o4[64 * j] = pk4_f8(x.x, x.y, x.z, x.w); }
#pragma unroll
                for (int o = 1; o < 16; o <<= 1) s += lane_get(s, lane ^ o);
                s = sum_fq(s);
                if (lane < 4) SSQ[(size_t)m * 4 + lane] = lane == 0 ? s : 0.f; } }
        }
    }
    SEAM(0);

#pragma unroll 1
    for (int l = 0; l < DEPTH; ++l) {
        const int pb = 1 + 6 * l;
        if (IN(pb)) for (int rep_ = 0; rep_ < REPS(0); ++rep_) { PTRS; pg8::Gemm g{XA, WIN, M, NMIX, D, D, D}; pg8::StaticOrder S; S.init(M, NMIX, G, (int)blockIdx.x);
          pg8::EpiP1 E{PROJ, SMALL, SSQ, INP(5) + l * 64, INP(6) + l * 64, INP(11) + l * 64, INP(12) + l * 64};
          pg8::gemm_phase<pg8::EpiP1, pg8::StaticOrder, true, true>(lds, g, S, E); }
        SEAM(pb);
        if (IN(pb + 1)) for (int rep_ = 0; rep_ < REPS(1); ++rep_) { PTRS;
          for (int r2 = 0; r2 < REPS(11); ++r2) fox_phase((char*)lds_, PROJ, SMALL, INP(4) + l * 4, Y); for (int r2 = 0; r2 < REPS(12); ++r2) swa_phase(lds, PROJ, INP(1), INP(13) + l * 8, Y); for (int r2 = 0; r2 < REPS(13); ++r2) conv_phase(PROJ, INP(7) + l * 768, Y); __syncthreads(); for (int r2 = 0; r2 < REPS(14); ++r2) mlstm_phase(lds, PROJ, SMALL, INP(8) + l * 4, INP(9) + l * 4, INP(10) + l * 256, Y); __syncthreads(); }
        SEAM(pb + 1);
        if (IN(pb + 2)) for (int rep_ = 0; rep_ < REPS(2); ++rep_) { PTRS; pg8::Gemm g{(const bf16*)((const unsigned char*)OUTP() + OUT_XA8), (const bf16*)(ws + WS_W8 + (size_t)l * 4 * MiB), M, 4096, D / 2, D / 2, D / 2};
          pg8::EpiGateS E{(pg8::u32x4*)(ws + WS_SLAB) + (size_t)blockIdx.x * 32768, SSQ};
          const int xcd = (int)blockIdx.x & 7, jw = (int)blockIdx.x >> 3, per = G >> 3;
#pragma unroll 1
          for (int idx = jw; idx < 64; idx += per) { const int pm_ = 16 * xcd + (idx >> 2), pp_ = idx & 3; const pg8::FourUnit s4{pm_, pp_};
              { const int t_ = ltid(); if (t_ < pg8::BM) ((LAS float*)(lds + pg8::RT_OFF))[t_] = rstd_of(SSQ, pm_ * pg8::BM + t_) * (-LOG2E / 64.f); __syncthreads(); }
              for (int r2 = 0; r2 < REPS(21); ++r2) pg8::gemm_phase<pg8::EpiGateS, pg8::FourUnit, true, true, 1, true>(lds, g, s4, E); for (int r2 = 0; r2 < REPS(22); ++r2) pg8::merge_gemm(lds, pm_, pp_, Y, WBR, XB, E.slab); if (DUP_PH == 23) pg8::merge_gemm<true>(lds, pm_, pp_, Y, WBR, (bf16*)OUTP(), E.slab); } }
        SEAM(pb + 2);
        if (IN(pb + 3)) { PTRS; pg8::Gemm g{XB, WMO, M, D, D, D, D}; pg8::StaticOrder S; S.init(M, D, G, (int)blockIdx.x);
          pg8::EpiRes E{XA, nullptr, SSQ, nullptr};
          pg8::gemm_phase<pg8::EpiRes, pg8::StaticOrder, true, true>(lds, g, S, E); }
        SEAM(pb + 3);
        if (IN(pb + 4)) for (int rep_ = 0; rep_ < REPS(4); ++rep_) { PTRS; pg8::Gemm g{XA, WGU, M, 2 * DFF, D, D, D}; pg8::StaticOrder S; S.init(M, 2 * DFF, G, (int)blockIdx.x);
          pg8::EpiFFN E{ACT, SSQ};
          pg8::gemm_phase<pg8::EpiFFN, pg8::StaticOrder, true, true>(lds, g, S, E); }
        SEAM(pb + 4);
        if (IN(pb + 5)) { PTRS; pg8::Gemm g{ACT, WD, M, D, DFF, DFF, DFF}; pg8::StaticOrder S; S.init(M, D, G, (int)blockIdx.x);
          pg8::EpiRes E{XA, l == DEPTH - 1 ? OUTP() : nullptr, l == DEPTH - 1 ? nullptr : SSQ, l == DEPTH - 1 ? nullptr : (unsigned char*)OUTP() + OUT_XA8};
          pg8::gemm_phase<pg8::EpiRes, pg8::StaticOrder, true, true>(lds, g, S, E); }
        if (l < DEPTH - 1) SEAM(pb + 5);
    }
}

extern "C" void kernel_launch(void* const* d_in, const int* in_sizes, int n_in, void* d_out, int out_size, void* d_ws, size_t ws_size, hipStream_t stream) {
    static int grid = 0;
    if (grid == 0) {
        if (n_in != 23 || ws_size < WS_END || out_size != M * D || in_sizes[0] != M * D) { fprintf(stderr, "kernel_launch: unexpected shapes n_in %d ws %zu out %d\n", n_in, ws_size, out_size); grid = -1; return; }
        int dev = 0, cus = 0, per_cu = 0;
        if (hipGetDevice(&dev) != hipSuccess || hipDeviceGetAttribute(&cus, hipDeviceAttributeMultiprocessorCount, dev) != hipSuccess) { grid = -1; return; }
        if (hipFuncSetAttribute((const void*)fwd, hipFuncAttributeMaxDynamicSharedMemorySize, LDS_BYTES) != hipSuccess) { fprintf(stderr, "kernel_launch: hipFuncSetAttribute failed\n"); grid = -1; return; }
        if (hipOccupancyMaxActiveBlocksPerMultiprocessor(&per_cu, (const void*)fwd, NWAVES * 64, LDS_BYTES) != hipSuccess || per_cu < 1) fprintf(stderr, "kernel_launch: occupancy query reports %d\n", per_cu);
        (void)hipGetLastError();
        grid = cus;
    }
    if (grid < 0) return;
    if (hipMemsetAsync((char*)d_ws + WS_CTL, 0, CTL_ZERO_BYTES, stream) != hipSuccess) return;
    Args a{};
    for (int i = 0; i < 23; ++i) a.in[i] = (const float*)d_in[i];
    a.out = (float*)d_out; a.ws = (unsigned char*)d_ws;
    constexpr int NPH = 1 + 6 * DEPTH;
    if (MK_PER_PHASE) { for (int p = 0; p < NPH; ++p) { a.ph_lo = p; a.ph_hi = p + 1; hipLaunchKernelGGL(fwd, dim3(grid), dim3(NWAVES * 64), LDS_BYTES, stream, a); } }
    else { a.ph_lo = 0; a.ph_hi = NPH; hipLaunchKernelGGL(fwd, dim3(grid), dim3(NWAVES * 64), LDS_BYTES, stream, a); }
}
```
